# Optimizing an MI355X kernel written in HIP

```python
import jax, jax.numpy as jnp
from jax import lax
import numpy as np

D_MODEL = 1024
BATCH = 8
SEQ = 4096
DEPTH = 2
DEC_BATCH = 16
DEC_SEQ = 2048
PAST_LEN = 128

GRID_W = 64
POOL_WIDTH = 512
POOL_GROUPS = 4
POOL_GROUP_DIM = POOL_WIDTH // POOL_GROUPS
POOL_WINDOWS = (2, 4, 8, 16)
MLSTM_HEADS = 4
MLSTM_HEAD_DIM = 128
MLSTM_WIDTH = MLSTM_HEADS * MLSTM_HEAD_DIM
MLSTM_CHUNK = 128
CONV_WIDTH = 3
N_DIRS = 2
IN0_SIZES = (POOL_WIDTH, POOL_WIDTH, MLSTM_WIDTH, MLSTM_WIDTH, MLSTM_WIDTH, MLSTM_WIDTH, N_DIRS * MLSTM_HEADS, N_DIRS * MLSTM_HEADS)
IN0_WIDTH = sum(IN0_SIZES)
IN0_SPLIT_POINTS = tuple(int(s) for s in np.cumsum(IN0_SIZES)[:-1])
OUT0_WIDTH = POOL_WIDTH + MLSTM_WIDTH
ATTN_HEADS = 8
KV_HEADS = 2
HEAD_DIM = 128
ATTN_WIDTH = ATTN_HEADS * HEAD_DIM
KV_WIDTH = KV_HEADS * HEAD_DIM
Q_BLOCK = 128
ROPE_THETA = 10000.0
AXIS_DIM = HEAD_DIM // 2
IN1_SIZES = (ATTN_WIDTH, KV_WIDTH, KV_WIDTH, ATTN_WIDTH)
IN1_WIDTH = sum(IN1_SIZES)
IN1_SPLIT_POINTS = tuple(int(s) for s in np.cumsum(IN1_SIZES)[:-1])
ALPHA = (2 * DEPTH) ** 0.25
BETA = (8 * DEPTH) ** -0.25
LN_EPS = 1e-5
RMS_EPS = 1e-6
M_INIT = -1e30
N_EVEN = (DEPTH + 1) // 2
N_ODD = DEPTH // 2

kernel_name = 'hybrid_pool_mlstm_axial_gqa_encoder'


def layer_norm(x, g, b):
    xf = x.astype(jnp.float32)
    mu = xf.mean(-1, keepdims=True)
    var = jnp.square(xf - mu).mean(-1, keepdims=True)
    return ((xf - mu) * lax.rsqrt(var + LN_EPS) * g + b).astype(x.dtype)


def rms_norm(x, g):
    xf = x.astype(jnp.float32)
    return (xf * lax.rsqrt(jnp.square(xf).mean(-1, keepdims=True) + RMS_EPS) * g).astype(x.dtype)


def centred_pool_mixer(xa, w_pool, pool_scale):
    B, T, _ = xa.shape
    xf = xa.astype(jnp.float32)
    cs = jnp.concatenate([jnp.zeros((B, 1, POOL_WIDTH), jnp.float32), jnp.cumsum(xf, axis=1)], axis=1)
    t = jnp.arange(T)
    groups = []
    for g, w in enumerate(POOL_WINDOWS):
        left = w // 2
        right = w - 1 - left
        lo = jnp.clip(t - left, 0, T)
        hi = jnp.clip(t + right + 1, 0, T)
        sl = slice(g * POOL_GROUP_DIM, (g + 1) * POOL_GROUP_DIM)
        seg = cs[:, :, sl]
        cnt = (hi - lo).astype(jnp.float32)
        mean = (seg[:, hi] - seg[:, lo]) / cnt[None, :, None]
        groups.append(mean - xf[:, :, sl])
    pooled = jnp.stack(groups, axis=2).astype(xa.dtype)
    mixed = jnp.einsum('btgc,gcd->btgd', pooled, w_pool)
    return mixed.reshape(B, T, POOL_WIDTH) * pool_scale


def centred_depthwise_conv(x, w, b):
    T = x.shape[1]
    pad = CONV_WIDTH // 2
    xp = jnp.pad(x, ((0, 0), (pad, CONV_WIDTH - 1 - pad), (0, 0)))
    return sum(xp[:, j:j + T] * w[j] for j in range(CONV_WIDTH)) + b


def mlstm_chunkwise(q, k, v, ig, lf):
    B, T, H, dh = q.shape
    L = MLSTM_CHUNK
    nc = T // L

    def chunks(a):
        return jnp.moveaxis(a.reshape((B, nc, L) + a.shape[2:]), 1, 0).swapaxes(2, 3)

    qc = chunks(q.astype(jnp.float32))
    kc = chunks(k.astype(jnp.float32) * (dh ** -0.5))
    vc = chunks(v.astype(jnp.float32))
    ic = chunks(ig)
    fc = chunks(lf)
    causal = jnp.tril(jnp.ones((L, L), dtype=bool))

    def step(carry, inp):
        C, n, m = carry
        qj, kj, vj, ij, fj = inp
        g = jnp.cumsum(fj, axis=-1)
        G = g[..., -1]
        dmat = jnp.where(causal, g[..., :, None] - g[..., None, :] + ij[..., None, :], -jnp.inf)
        inter = g + m[..., None]
        m_row = jnp.maximum(inter, dmat.max(-1))
        s = jnp.einsum('bhld,bhsd->bhls', qj, kj) * jnp.exp(dmat - m_row[..., None])
        ex = jnp.exp(inter - m_row)
        num = jnp.einsum('bhls,bhsd->bhld', s, vj) + ex[..., None] * jnp.einsum('bhvk,bhlk->bhlv', C, qj)
        den = s.sum(-1) + ex * jnp.einsum('bhk,bhlk->bhl', n, qj)
        h = num / jnp.maximum(jnp.abs(den), jnp.exp(-m_row))[..., None]
        w_s = G[..., None] - g + ij
        m_new = jnp.maximum(G + m, w_s.max(-1))
        decay = jnp.exp(G + m - m_new)
        ws = jnp.exp(w_s - m_new[..., None])
        C_new = decay[..., None, None] * C + jnp.einsum('bhs,bhsv,bhsk->bhvk', ws, vj, kj)
        n_new = decay[..., None] * n + jnp.einsum('bhs,bhsk->bhk', ws, kj)
        return (C_new, n_new, m_new), h

    init = (jnp.zeros((B, H, dh, dh), jnp.float32), jnp.zeros((B, H, dh), jnp.float32), jnp.full((B, H), M_INIT, jnp.float32))
    _, h = lax.scan(step, init, (qc, kc, vc, ic, fc))
    return jnp.moveaxis(h.swapaxes(2, 3), 0, 1).reshape(B, T, H, dh)


def even_mixer(x, w_in, w_pool, pool_scale, conv_w, conv_b, w_q, w_k, b_gate_i, b_gate_f, mh_norm_g, skip, w_out):
    B, T, _ = x.shape
    H, dh = MLSTM_HEADS, MLSTM_HEAD_DIM
    proj = x @ w_in
    xa, za, xb, vb, ob, zb, gi, gf = jnp.split(proj, IN0_SPLIT_POINTS, axis=-1)
    out_a = centred_pool_mixer(xa, w_pool, pool_scale) * jax.nn.silu(za)
    xc = jax.nn.silu(centred_depthwise_conv(xb, conv_w, conv_b))
    xch = xc.reshape(B, T, H, dh)
    q = jnp.einsum('bthd,hde->bthe', xch, w_q)
    k = jnp.einsum('bthd,hde->bthe', xch, w_k)
    v = vb.reshape(B, T, H, dh)
    ig = (gi.reshape(B, T, N_DIRS, H) + b_gate_i).astype(jnp.float32)
    lf = jax.nn.log_sigmoid((gf.reshape(B, T, N_DIRS, H) + b_gate_f).astype(jnp.float32))
    rev = lambda a: jnp.flip(a, axis=1)
    h_fwd = mlstm_chunkwise(q, k, v, ig[:, :, 0], lf[:, :, 0])
    h_bwd = rev(mlstm_chunkwise(rev(q), rev(k), rev(v), rev(ig[:, :, 1]), rev(lf[:, :, 1])))
    h = (h_fwd + h_bwd) * jax.nn.sigmoid(ob.astype(jnp.float32)).reshape(B, T, H, dh)
    mu = h.mean(-1, keepdims=True)
    var = jnp.square(h - mu).mean(-1, keepdims=True)
    hn = ((h - mu) * lax.rsqrt(var + LN_EPS)).reshape(B, T, MLSTM_WIDTH) * mh_norm_g
    out_b = (hn.astype(x.dtype) + skip * xc) * jax.nn.silu(zb)
    return jnp.concatenate([out_a, out_b], axis=-1) @ w_out


def axial_rope_tables(T):
    rows = T // GRID_W
    t_row = jnp.repeat(jnp.arange(rows, dtype=jnp.float32), GRID_W)
    t_col = jnp.tile(jnp.arange(GRID_W, dtype=jnp.float32), rows)
    n_freq = AXIS_DIM // 2
    inv = ROPE_THETA ** (-jnp.arange(n_freq, dtype=jnp.float32) / n_freq)
    ang = jnp.stack([t_row[:, None] * inv, t_col[:, None] * inv], axis=1)
    return jnp.cos(ang), jnp.sin(ang)


def apply_axial_rope(x, cos, sin):
    B, T, H, _ = x.shape
    n_freq = AXIS_DIM // 2
    xr = x.reshape(B, T, H, 2, 2, n_freq)
    x1, x2 = xr[..., 0, :], xr[..., 1, :]
    c = cos.astype(x.dtype)[None, :, None]
    s = sin.astype(x.dtype)[None, :, None]
    out = jnp.stack([x1 * c - x2 * s, x2 * c + x1 * s], axis=-2)
    return out.reshape(B, T, H, HEAD_DIM)


def blocked_attention(q, k, v):
    B, T = q.shape[:2]
    nblk = T // Q_BLOCK
    grp = ATTN_HEADS // KV_HEADS
    qb = q.reshape(B, nblk, Q_BLOCK, KV_HEADS, grp, HEAD_DIM).transpose(1, 0, 2, 3, 4, 5)
    scale = HEAD_DIM ** -0.5

    def one_block(qblk):
        s = jnp.einsum('bqkgd,bskd->bkgqs', qblk, k).astype(jnp.float32) * scale
        p = jax.nn.softmax(s, axis=-1).astype(v.dtype)
        return jnp.einsum('bkgqs,bskd->bqkgd', p, v)

    o = lax.map(one_block, qb)
    return o.transpose(1, 0, 2, 3, 4, 5).reshape(B, T, ATTN_WIDTH)


def odd_mixer(x, w_in, q_norm_g, k_norm_g, w_out):
    B, T, _ = x.shape
    proj = x @ w_in
    q, k, v, z = jnp.split(proj, IN1_SPLIT_POINTS, axis=-1)
    q = rms_norm(q.reshape(B, T, ATTN_HEADS, HEAD_DIM), q_norm_g)
    k = rms_norm(k.reshape(B, T, KV_HEADS, HEAD_DIM), k_norm_g)
    v = v.reshape(B, T, KV_HEADS, HEAD_DIM)
    cos, sin = axial_rope_tables(T)
    q = apply_axial_rope(q, cos, sin)
    k = apply_axial_rope(k, cos, sin)
    o = blocked_attention(q, k, v)
    return (o * jax.nn.silu(z)) @ w_out


def trunk(x, w_in_even, w_pool, pool_scale, conv_w, conv_b, w_q_m, w_k_m, b_gate_i, b_gate_f, mh_norm_g, skip, w_out_even, w_in_odd, q_norm_g, k_norm_g, w_out_odd, ln_g, ln_b):
    for layer in range(DEPTH):
        j = layer // 2
        if layer % 2 == 0:
            mix = even_mixer(x, w_in_even[j], w_pool[j], pool_scale[j], conv_w[j], conv_b[j], w_q_m[j], w_k_m[j], b_gate_i[j], b_gate_f[j], mh_norm_g[j], skip[j], w_out_even[j])
        else:
            mix = odd_mixer(x, w_in_odd[j], q_norm_g[j], k_norm_g[j], w_out_odd[j])
        x = layer_norm(ALPHA * x + mix, ln_g[layer], ln_b[layer])
    return x


def setup_inputs(seed: int = 0) -> dict:
    key = jax.random.key(seed)
    ks = jax.random.split(key, 24)
    f32 = jnp.float32
    nrm = lambda k, shape: jax.random.normal(k, shape, f32)
    return {
        'x_prompt': nrm(ks[0], (BATCH, SEQ, D_MODEL)),
        'x_sample': nrm(ks[1], (DEC_BATCH, DEC_SEQ, D_MODEL)),
        'w_in_even': nrm(ks[2], (N_EVEN, D_MODEL, IN0_WIDTH)) * D_MODEL ** -0.5,
        'w_pool': nrm(ks[3], (N_EVEN, POOL_GROUPS, POOL_GROUP_DIM, POOL_GROUP_DIM)) * POOL_GROUP_DIM ** -0.5,
        'pool_scale': 1.0 + 0.1 * nrm(ks[4], (N_EVEN, POOL_WIDTH)),
        'conv_w': nrm(ks[5], (N_EVEN, CONV_WIDTH, MLSTM_WIDTH)) * CONV_WIDTH ** -0.5,
        'conv_b': 0.02 * nrm(ks[6], (N_EVEN, MLSTM_WIDTH)),
        'w_q_m': nrm(ks[7], (N_EVEN, MLSTM_HEADS, MLSTM_HEAD_DIM, MLSTM_HEAD_DIM)) * MLSTM_HEAD_DIM ** -0.5,
        'w_k_m': nrm(ks[8], (N_EVEN, MLSTM_HEADS, MLSTM_HEAD_DIM, MLSTM_HEAD_DIM)) * MLSTM_HEAD_DIM ** -0.5,
        'b_gate_i': 0.1 * nrm(ks[9], (N_EVEN, N_DIRS, MLSTM_HEADS)),
        'b_gate_f': 3.0 + 3.0 * jax.random.uniform(ks[10], (N_EVEN, N_DIRS, MLSTM_HEADS), f32),
        'mh_norm_g': 1.0 + 0.02 * nrm(ks[11], (N_EVEN, MLSTM_WIDTH)),
        'skip': 1.0 + 0.1 * nrm(ks[12], (N_EVEN, MLSTM_WIDTH)),
        'w_out_even': nrm(ks[13], (N_EVEN, OUT0_WIDTH, D_MODEL)) * (OUT0_WIDTH ** -0.5 * BETA),
        'w_in_odd': nrm(ks[14], (N_ODD, D_MODEL, IN1_WIDTH)) * D_MODEL ** -0.5,
        'q_norm_g': 1.0 + 0.02 * nrm(ks[15], (N_ODD, HEAD_DIM)),
        'k_norm_g': 1.0 + 0.02 * nrm(ks[16], (N_ODD, HEAD_DIM)),
        'w_out_odd': nrm(ks[17], (N_ODD, ATTN_WIDTH, D_MODEL)) * (ATTN_WIDTH ** -0.5 * BETA),
        'ln_g': 1.0 + 0.02 * nrm(ks[18], (DEPTH, D_MODEL)),
        'ln_b': 0.02 * nrm(ks[19], (DEPTH, D_MODEL)),
    }


def reference(x_prompt, x_sample, w_in_even, w_pool, pool_scale, conv_w, conv_b, w_q_m, w_k_m, b_gate_i, b_gate_f, mh_norm_g, skip, w_out_even, w_in_odd, q_norm_g, k_norm_g, w_out_odd, ln_g, ln_b):
    y_prompt = trunk(x_prompt, w_in_even, w_pool, pool_scale, conv_w, conv_b, w_q_m, w_k_m, b_gate_i, b_gate_f, mh_norm_g, skip, w_out_even, w_in_odd, q_norm_g, k_norm_g, w_out_odd, ln_g, ln_b)
    y_sample = trunk(x_sample, w_in_even, w_pool, pool_scale, conv_w, conv_b, w_q_m, w_k_m, b_gate_i, b_gate_f, mh_norm_g, skip, w_out_even, w_in_odd, q_norm_g, k_norm_g, w_out_odd, ln_g, ln_b)
    return (y_prompt, y_sample)
```

```cpp
#include <hip/hip_runtime.h>
#include <hip/hip_cooperative_groups.h>
#include <cstdio>
namespace cg = cooperative_groups;

#ifndef MK_MULTI
#define MK_MULTI 0
#endif

#ifndef REP_PH
#define REP_PH -1
#endif
typedef unsigned short bf16_t;
typedef short bf16x8 __attribute__((ext_vector_type(8)));
typedef short s16x4 __attribute__((ext_vector_type(4)));
typedef float f32x4 __attribute__((ext_vector_type(4)));
typedef float f32x16 __attribute__((ext_vector_type(16)));
typedef unsigned u32x4 __attribute__((ext_vector_type(4)));
typedef unsigned u32x2 __attribute__((ext_vector_type(2)));
#define LAS __attribute__((address_space(3)))

constexpr int MTOK = 65536, NPROMPT = 32768, DM = 1024;
constexpr int LDP = 3072;
constexpr size_t P0_BYTES = (size_t)MTOK * LDP * 2;
constexpr size_t OFF_WT0 = P0_BYTES;
constexpr size_t OFF_WO0T = OFF_WT0 + (size_t)3328 * 1024 * 2;
constexpr size_t OFF_WT1 = OFF_WO0T + (size_t)1024 * 1024 * 2;
constexpr size_t OFF_WO1T = OFF_WT1 + (size_t)2560 * 1024 * 2;
constexpr size_t OFF_WPT = OFF_WO1T + (size_t)1024 * 1024 * 2;
constexpr size_t OFF_WQT = OFF_WPT + 131072;
constexpr size_t OFF_WKT = OFF_WQT + 131072;
constexpr size_t OFF_GATES = OFF_WKT + 131072;
constexpr size_t OFF_BAR = OFF_GATES + (size_t)MTOK * 16 * 4;
constexpr size_t OFF_SCR = OFF_BAR + 3456 * 4;
constexpr int SCR_ITEM = 32 * 384 + 64;
constexpr size_t OFF_ROPE = OFF_SCR + (size_t)192 * SCR_ITEM * 4;
constexpr size_t WS_END = OFF_ROPE + 64 * 32 * 2 * 4;
constexpr int LDS_BYTES = 136 * 1024;
constexpr float ALPHA = 1.41421356237309515f;

struct Params {
    const float* xp; const float* xs; const float* w_in_even; const float* w_pool; const float* pool_scale; const float* conv_w; const float* conv_b;
    const float* w_q; const float* w_k; const float* bgi; const float* bgf; const float* mh_g; const float* skip; const float* w_out_even;
    const float* w_in_odd; const float* qng; const float* kng; const float* w_out_odd; const float* ln_g; const float* ln_b;
    float* out; unsigned char* ws; int ph_lo, ph_hi;
};

__device__ __forceinline__ unsigned cvt_pk(float lo, float hi) { unsigned r; asm volatile("v_cvt_pk_bf16_f32 %0, %1, %2" : "=v"(r) : "v"(lo), "v"(hi)); return r; }
__device__ __forceinline__ float bflo(unsigned w) { return __uint_as_float(w << 16); }
__device__ __forceinline__ float bfhi(unsigned w) { return __uint_as_float(w & 0xffff0000u); }
__device__ __forceinline__ bf16_t f2bf(float f) { unsigned u = __float_as_uint(f); u += 0x7FFFu + ((u >> 16) & 1u); return (bf16_t)(u >> 16); }
__device__ __forceinline__ float sigm(float x) { return __frcp_rn(1.f + __expf(-x)); }
__device__ __forceinline__ float silu(float x) { return x * sigm(x); }
__device__ __forceinline__ int swz(int row, int chunk) { return row * 256 + ((chunk ^ (row & 15)) << 4); }

namespace pg8 {
constexpr int BM = 256, BK = 64, HALF = 128, HTB = HALF * BK * 2, STAGE_BYTES = 8 * HTB;
__device__ __forceinline__ int lds_byte(int r, int c) { const int st = (r >> 4) * 2 + (c >> 5), rr = r & 15, cc = c & 31, ob = rr * 64 + cc * 2; return st * 1024 + (ob ^ (((ob >> 9) & 1) << 5)); }
__device__ __forceinline__ void stage_rc(int b, int& R, int& C) { const int st = b / 1024, sb = b % 1024, sw = sb ^ (((sb >> 9) & 1) << 5); R = (st >> 1) * 16 + sw / 64; C = (st & 1) * 32 + (sw % 64) / 2; }
__device__ __forceinline__ int perm32(int rho) { const int n = rho >> 4, i = rho & 15; return 8 * (i >> 2) + 4 * n + (i & 3); }
struct Unit { int pm, pn; };
struct Gemm { const bf16_t* A; const bf16_t* Bt; int M, N, K, lda; };
struct StaticOrder {
    int nM, nN, nwg, G, c;
    __device__ void init(int M, int N, int G_, int c_) { nM = M / BM; nN = N / BM; nwg = nM * nN; G = G_; c = c_; }
    __device__ bool next(int i, Unit& u) const {
        if (REP_PH == 1 && i >= 13 && i < 26) i -= 13;
        const long L = (long)i * G + c; if (L >= nwg) return false;
        int wgid = (int)L; { const int q = nwg / 8, r = nwg % 8, xcd = wgid % 8, off = wgid / 8; wgid = (xcd < r ? xcd * (q + 1) : r * (q + 1) + (xcd - r) * q) + off; }
        const int nig = 8 * nN, gid = wgid / nig, fm = gid * 8, gsz = (nM - fm) < 8 ? (nM - fm) : 8;
        u.pm = fm + ((wgid % nig) % gsz); u.pn = (wgid % nig) / gsz; return true;
    }
};
struct PanelOrder {
    int pm, nN;
    __device__ bool next(int i, Unit& u) const { if (REP_PH == 12 && nN == 4) { if (i >= 8) return false; u.pm = pm; u.pn = i & 3; return true; }
        if (i >= nN) return false; u.pm = pm; u.pn = i; return true; }
};

template <class Epi, class Sched>
__device__ __forceinline__ void gemm_phase(LAS unsigned char* lds, const Gemm g, const Sched& S, const Epi& E) {
    int tid = threadIdx.x; asm volatile("" : "+v"(tid));
    const int wid = __builtin_amdgcn_readfirstlane(tid >> 6), lane = tid & 63, wr = wid >> 2, wc = wid & 3, fr = lane & 15, fq = lane >> 4;
    const int K = g.K, nt = K / BK, lda = g.lda;
    unsigned voffA[2], voffB[2];
#pragma unroll
    for (int i = 0; i < 2; ++i) { int R, C; stage_rc(tid * 16 + i * 8192, R, C); const int Rb = Epi::PERM ? ((R & ~31) + perm32(R & 31)) : R;
        voffA[i] = (unsigned)(R * lda + C) * 2u; voffB[i] = (unsigned)(Rb * K + C) * 2u; }
    const size_t kstep = (size_t)(BK * 2);
    const size_t hA = (size_t)HALF * lda * 2, hB = (size_t)HALF * K * 2;
    const size_t tA = 2 * hA, tB = 2 * hB;
    const unsigned ldsw = (unsigned)wid * 1024u;
    const int aoff = lds_byte(wr * 64 + fr, fq * 8), boff = lds_byte(wc * 32 + fr, fq * 8);
#define PG8_SA(b, h) (((b) * 2 + (h)) * HTB)
#define PG8_SB(b, h) ((4 + (b) * 2 + (h)) * HTB)
#define PG8_STAGE(bufoff, gbase, voff) do { const char* _gb = (const char*)(gbase); asm volatile("" : "+s"(_gb)); _Pragma("unroll") for (int _i = 0; _i < 2; ++_i) \
        __builtin_amdgcn_global_load_lds((const unsigned*)(_gb + (voff)[_i]), (LAS unsigned*)(lds + (bufoff) + ldsw + _i * 8192), 16, 0, 0); } while (0)
#define PG8_LDA(dst, b, h) do { _Pragma("unroll") for (int m = 0; m < 4; ++m) _Pragma("unroll") for (int k = 0; k < 2; ++k) dst[m][k] = *(const LAS bf16x8*)(lds + PG8_SA(b, h) + aoff + m * 2048 + k * 1024); } while (0)
#define PG8_LDB(dst, b, h) do { _Pragma("unroll") for (int n = 0; n < 2; ++n) _Pragma("unroll") for (int k = 0; k < 2; ++k) dst[n][k] = *(const LAS bf16x8*)(lds + PG8_SB(b, h) + boff + n * 2048 + k * 1024); } while (0)
#define PG8_MMA(ai, bj, At, Bt) do { __builtin_amdgcn_s_setprio(1); _Pragma("unroll") for (int m = 0; m < 4; ++m) _Pragma("unroll") for (int n = 0; n < 2; ++n) _Pragma("unroll") for (int k = 0; k < 2; ++k) \
        acc[ai][bj][m][n] = __builtin_amdgcn_mfma_f32_16x16x32_bf16(Bt[n][k], At[m][k], acc[ai][bj][m][n], 0, 0, 0); __builtin_amdgcn_s_setprio(0); } while (0)
#define PG8_WAIT_V(n) asm volatile("s_waitcnt vmcnt(" #n ")" ::: "memory")
#define PG8_WAIT_L(n) asm volatile("s_waitcnt lgkmcnt(" #n ")" ::: "memory")
#define PG8_BAR __builtin_amdgcn_s_barrier()
#define PG8_SCHED __builtin_amdgcn_sched_barrier(0)
    Unit cur, nxt; int ui = 0;
    if (!S.next(0, cur)) return;
    f32x4 acc[2][2][4][2];
#pragma unroll
    for (int a = 0; a < 2; ++a)
#pragma unroll
        for (int b = 0; b < 2; ++b)
#pragma unroll
            for (int m = 0; m < 4; ++m)
#pragma unroll
                for (int n = 0; n < 2; ++n) acc[a][b][m][n] = (f32x4){0.f, 0.f, 0.f, 0.f};
    bf16x8 At[4][2], B0[2][2], B1[2][2];
    const char* cA = (const char*)g.A + (size_t)cur.pm * tA; const char* cB = (const char*)g.Bt + (size_t)cur.pn * tB;
    PG8_STAGE(PG8_SB(0, 0), cB, voffB); PG8_STAGE(PG8_SA(0, 0), cA, voffA); PG8_STAGE(PG8_SB(0, 1), cB + hB, voffB); PG8_STAGE(PG8_SA(0, 1), cA + hA, voffA);
    if (wr == 1) PG8_BAR;
    PG8_WAIT_V(4); PG8_BAR;
    PG8_STAGE(PG8_SB(1, 0), cB + kstep, voffB); PG8_STAGE(PG8_SA(1, 0), cA + kstep, voffA); PG8_STAGE(PG8_SB(1, 1), cB + hB + kstep, voffB);
    PG8_WAIT_V(6); PG8_BAR;
    for (;;) {
        const bool has_next = S.next(ui + 1, nxt);
        const char* nA = has_next ? (const char*)g.A + (size_t)nxt.pm * tA : cA; const char* nB = has_next ? (const char*)g.Bt + (size_t)nxt.pn * tB : cB;
        for (int t = 0; t < nt; t += 2) {
            const bool last = (t == nt - 2);
            const char* a1 = cA + (size_t)(t + 1) * kstep;
            const char* a2 = last ? nA : cA + (size_t)(t + 2) * kstep; const char* b2 = last ? nB : cB + (size_t)(t + 2) * kstep;
            const char* a3 = a2 + kstep; const char* b3 = b2 + kstep;
            PG8_LDB(B0, 0, 0); PG8_SCHED; PG8_LDA(At, 0, 0); PG8_STAGE(PG8_SA(1, 1), a1 + hA, voffA);
            PG8_WAIT_L(8); PG8_BAR; PG8_WAIT_L(0); PG8_MMA(0, 0, At, B0); PG8_BAR; PG8_SCHED;
            PG8_LDB(B1, 0, 1); PG8_STAGE(PG8_SB(0, 0), b2, voffB);
            PG8_BAR; PG8_WAIT_L(0); PG8_MMA(0, 1, At, B1); PG8_BAR;
            PG8_LDA(At, 0, 1); PG8_STAGE(PG8_SA(0, 0), a2, voffA);
            PG8_BAR; PG8_WAIT_L(0); PG8_MMA(1, 0, At, B0); PG8_BAR; PG8_SCHED;
            PG8_STAGE(PG8_SB(0, 1), b2 + hB, voffB);
            PG8_WAIT_V(6); PG8_BAR; PG8_MMA(1, 1, At, B1); PG8_BAR;
            PG8_LDB(B0, 1, 0); PG8_SCHED; PG8_LDA(At, 1, 0); PG8_STAGE(PG8_SA(0, 1), a2 + hA, voffA);
            PG8_WAIT_L(8); PG8_BAR; PG8_WAIT_L(0); PG8_MMA(0, 0, At, B0); PG8_BAR; PG8_SCHED;
            PG8_LDB(B1, 1, 1); PG8_STAGE(PG8_SB(1, 0), b3, voffB);
            PG8_BAR; PG8_WAIT_L(0); PG8_MMA(0, 1, At, B1); PG8_BAR;
            PG8_LDA(At, 1, 1); PG8_STAGE(PG8_SA(1, 0), a3, voffA);
            PG8_BAR; PG8_WAIT_L(0); PG8_MMA(1, 0, At, B0); PG8_BAR; PG8_SCHED;
            PG8_STAGE(PG8_SB(1, 1), b3 + hB, voffB);
            PG8_WAIT_V(6); PG8_BAR; PG8_MMA(1, 1, At, B1); PG8_BAR;
        }
        E(acc, cur, wr, wc, fr, fq);
        if (!has_next) break;
#pragma unroll
        for (int a = 0; a < 2; ++a)
#pragma unroll
            for (int b = 0; b < 2; ++b)
#pragma unroll
                for (int m = 0; m < 4; ++m)
#pragma unroll
                    for (int n = 0; n < 2; ++n) acc[a][b][m][n] = (f32x4){0.f, 0.f, 0.f, 0.f};
        cur = nxt; cA = nA; cB = nB; ++ui;
    }
    PG8_WAIT_V(0);
    if (wr == 0) PG8_BAR;
    PG8_BAR;
#undef PG8_SA
#undef PG8_SB
#undef PG8_STAGE
#undef PG8_LDA
#undef PG8_LDB
#undef PG8_MMA
#undef PG8_WAIT_V
#undef PG8_WAIT_L
#undef PG8_BAR
#undef PG8_SCHED
}

struct EpiP0 {
    static constexpr bool PERM = true;
    bf16_t* P0; float* gates;
    __device__ __forceinline__ void operator()(const f32x4 (&acc)[2][2][4][2], const Unit& u, int wr, int wc, int fr, int fq) const {
        const int row0 = u.pm * BM + wr * 64 + fr;
        if (u.pn < 12) {
            const int col0 = u.pn * BM + wc * 32 + 8 * fq;
#pragma unroll
            for (int ai = 0; ai < 2; ++ai)
#pragma unroll
                for (int m = 0; m < 4; ++m) { bf16_t* rowp = P0 + (size_t)(row0 + ai * HALF + m * 16) * LDP + col0;
#pragma unroll
                    for (int bj = 0; bj < 2; ++bj) { const f32x4 v0 = acc[ai][bj][m][0], v1 = acc[ai][bj][m][1];
                        u32x4 w; w.x = cvt_pk(v0[0], v0[1]); w.y = cvt_pk(v0[2], v0[3]); w.z = cvt_pk(v1[0], v1[1]); w.w = cvt_pk(v1[2], v1[3]);
                        *(u32x4*)(rowp + bj * HALF) = w; } }
        } else if (wc == 0 && fq < 2) {
#pragma unroll
            for (int ai = 0; ai < 2; ++ai)
#pragma unroll
                for (int m = 0; m < 4; ++m) { float* gp = gates + (size_t)(row0 + ai * HALF + m * 16) * 16 + 8 * fq;
                    *(f32x4*)gp = acc[ai][0][m][0]; *(f32x4*)(gp + 4) = acc[ai][0][m][1]; }
        }
    }
};
struct EpiBf {
    static constexpr bool PERM = true;
    bf16_t* O;
    __device__ __forceinline__ void operator()(const f32x4 (&acc)[2][2][4][2], const Unit& u, int wr, int wc, int fr, int fq) const {
        const int row0 = u.pm * BM + wr * 64 + fr, col0 = u.pn * BM + wc * 32 + 8 * fq; const bool gate = u.pn >= 6;
#pragma unroll
        for (int ai = 0; ai < 2; ++ai)
#pragma unroll
            for (int m = 0; m < 4; ++m) { bf16_t* rowp = O + (size_t)(row0 + ai * HALF + m * 16) * LDP + col0;
#pragma unroll
                for (int bj = 0; bj < 2; ++bj) { f32x4 v0 = acc[ai][bj][m][0], v1 = acc[ai][bj][m][1];
                    if (gate) {
#pragma unroll
                        for (int e = 0; e < 4; ++e) { v0[e] = silu(v0[e]); v1[e] = silu(v1[e]); } }
                    u32x4 w; w.x = cvt_pk(v0[0], v0[1]); w.y = cvt_pk(v0[2], v0[3]); w.z = cvt_pk(v1[0], v1[1]); w.w = cvt_pk(v1[2], v1[3]);
                    *(u32x4*)(rowp + bj * HALF) = w; } }
    }
};
template <int RES_BF16> struct EpiRes {
    static constexpr bool PERM = true;
    bf16_t* Y; const bf16_t* xb;
    __device__ __forceinline__ void operator()(const f32x4 (&acc)[2][2][4][2], const Unit& u, int wr, int wc, int fr, int fq) const {
        const int row0 = u.pm * BM + wr * 64 + fr, col0 = u.pn * BM + wc * 32 + 8 * fq;
#pragma unroll
        for (int ai = 0; ai < 2; ++ai) {
            u32x4 res[4][2];
            if (RES_BF16) {
#pragma unroll
                for (int m = 0; m < 4; ++m)
#pragma unroll
                    for (int bj = 0; bj < 2; ++bj) res[m][bj] = *(const u32x4*)(xb + (size_t)(row0 + ai * HALF + m * 16) * 1024 + col0 + bj * HALF);
            }
#pragma unroll
            for (int m = 0; m < 4; ++m) { const int row = row0 + ai * HALF + m * 16; bf16_t* yp = Y + (size_t)row * LDP + col0;
#pragma unroll
                for (int bj = 0; bj < 2; ++bj) { f32x4 v0 = acc[ai][bj][m][0], v1 = acc[ai][bj][m][1];
                    if (RES_BF16) { const u32x4 w = res[m][bj];
                        v0 += (f32x4){bflo(w.x), bfhi(w.x), bflo(w.y), bfhi(w.y)} * ALPHA; v1 += (f32x4){bflo(w.z), bfhi(w.z), bflo(w.w), bfhi(w.w)} * ALPHA; }
                    u32x4 o; o.x = cvt_pk(v0[0], v0[1]); o.y = cvt_pk(v0[2], v0[3]); o.z = cvt_pk(v1[0], v1[1]); o.w = cvt_pk(v1[2], v1[3]);
                    *(u32x4*)(yp + bj * HALF) = o; } }
            __builtin_amdgcn_sched_barrier(0);
        }
    }
};
}

template <int NB> __device__ __forceinline__ void mm16(f32x4 (&acc)[NB], const unsigned char* Xs, const bf16x8 (&yf)[4], int lane) {
    const int i = lane & 15, kq = lane >> 4;
#pragma unroll
    for (int ks = 0; ks < 4; ++ks)
#pragma unroll
        for (int nb = 0; nb < NB; ++nb) {
            const bf16x8 x = *(const bf16x8*)(Xs + swz(nb * 16 + i, ks * 4 + kq));
            acc[nb] = __builtin_amdgcn_mfma_f32_16x16x32_bf16(x, yf[ks], acc[nb], 0, 0, 0);
            if ((nb & 3) == 3) __builtin_amdgcn_sched_barrier(0);
        }
}
__device__ __forceinline__ void ldfrag(bf16x8 (&f)[4], const unsigned char* Ts, int rb, int lane) {
#pragma unroll
    for (int ks = 0; ks < 4; ++ks) f[ks] = *(const bf16x8*)(Ts + swz(rb * 16 + (lane & 15), ks * 4 + (lane >> 4)));
}
__device__ __forceinline__ void stage_tile(unsigned char* dst, const bf16_t* src, int ld) {
    for (int idx = threadIdx.x; idx < 2048; idx += 512) { const int row = idx >> 4, ch = idx & 15;
        *(u32x4*)(dst + swz(row, ch)) = *(const u32x4*)(src + (size_t)row * ld + ch * 8); }
}

__device__ void phase_prep(const Params& p, unsigned char* smem) {
    const int tid = threadIdx.x;
    if (blockIdx.x == 0) for (int i = tid; i < 3456; i += 512) ((unsigned*)(p.ws + OFF_BAR))[i] = 0u;
    if (blockIdx.x == 1) for (int i = tid; i < 2048; i += 512) { const float inv = exp2f(-(float)(i & 31) * (13.287712379549449f / 32.f)); float sn, cs; __sincosf((float)(i >> 5) * inv, &sn, &cs);
        ((float2*)(p.ws + OFF_ROPE))[i] = make_float2(cs, sn); }
    bf16_t* XB = (bf16_t*)p.out;
    const size_t n8 = (size_t)MTOK * DM / 8, half8 = (size_t)NPROMPT * DM / 8;
    for (size_t i = (size_t)blockIdx.x * 512 + tid; i < n8; i += (size_t)gridDim.x * 512) {
        const float* src = i < half8 ? p.xp + i * 8 : p.xs + (i - half8) * 8;
        const f32x4 a = __builtin_nontemporal_load((const f32x4*)src), b = __builtin_nontemporal_load((const f32x4*)(src + 4));
        u32x4 w; w.x = cvt_pk(a[0], a[1]); w.y = cvt_pk(a[2], a[3]); w.z = cvt_pk(b[0], b[1]); w.w = cvt_pk(b[2], b[3]);
        *(u32x4*)(XB + i * 8) = w;
    }
    float* t = (float*)smem;
    for (int ti = blockIdx.x; ti < 2032; ti += gridDim.x) {
        const float* src; bf16_t* dst; int K, N, tn, li; float scale = 1.f;
        if (ti < 832) { src = p.w_in_even; dst = (bf16_t*)(p.ws + OFF_WT0); K = 1024; N = 3088; tn = 52; li = ti; }
        else if (ti < 1088) { src = p.w_out_even; dst = (bf16_t*)(p.ws + OFF_WO0T); K = 1024; N = 1024; tn = 16; li = ti - 832; }
        else if (ti < 1728) { src = p.w_in_odd; dst = (bf16_t*)(p.ws + OFF_WT1); K = 1024; N = 2560; tn = 40; li = ti - 1088; }
        else if (ti < 1984) { src = p.w_out_odd; dst = (bf16_t*)(p.ws + OFF_WO1T); K = 1024; N = 1024; tn = 16; li = ti - 1728; }
        else { const int si = ti - 1984, which = si >> 4, mat = (si >> 2) & 3; li = si & 3; K = 128; N = 128; tn = 2;
            if (which == 0) { src = p.w_pool + mat * 16384; dst = (bf16_t*)(p.ws + OFF_WPT) + mat * 16384; }
            else if (which == 1) { src = p.w_q + mat * 16384; dst = (bf16_t*)(p.ws + OFF_WQT) + mat * 16384; }
            else { src = p.w_k + mat * 16384; dst = (bf16_t*)(p.ws + OFF_WKT) + mat * 16384; scale = 0.08838834764831845f; } }
        const int k0 = (li / tn) * 64, n0 = (li % tn) * 64;
#pragma unroll
        for (int e = 0; e < 8; ++e) { const int idx = e * 512 + tid, kk = idx >> 6, nn = idx & 63, n = n0 + nn;
            t[kk * 65 + nn] = (n < N) ? src[(size_t)(k0 + kk) * N + n] * scale : 0.f; }
        __syncthreads();
#pragma unroll
        for (int e = 0; e < 8; ++e) { const int idx = e * 512 + tid, nn = idx >> 6, kk = idx & 63;
            dst[(size_t)(n0 + nn) * K + k0 + kk] = f2bf(t[kk * 65 + nn]); }
        __syncthreads();
    }
}

__device__ void phase_mix(const Params& p, unsigned char* smem) {
    int tid = threadIdx.x; asm volatile("" : "+v"(tid));
    const int wid = tid >> 6, lane = tid & 63, li = lane & 15, kq = lane >> 4;
    const bf16_t* P0 = (const bf16_t*)p.ws;
    bf16_t* CAT0 = (bf16_t*)p.out + (size_t)MTOK * 1024;
    bf16_t* Q0 = (bf16_t*)p.out; bf16_t* K0 = Q0 + (size_t)MTOK * 512;
    unsigned char* As = smem; unsigned char* Bs = smem + 32768; unsigned char* B2s = smem + 65536; unsigned char* halo = smem + 65536;
    const int g = blockIdx.x & 3;
    stage_tile(Bs, (const bf16_t*)(p.ws + OFF_WPT) + g * 16384, 128);
    const int tstep = gridDim.x >> 2, tlim = (REP_PH == 2 ? 1024 : 512);
#define TILE_DECODE(tile_) const int tile = (tile_) & 511; const int r0 = tile * 128; int T, ts0; \
        if (r0 < NPROMPT) { T = 4096; ts0 = r0 & 4095; } else { T = 2048; ts0 = (r0 - NPROMPT) & 2047; }
    {
        const int left = 1 << g, right = (1 << g) - 1;
        u32x4 hreg[5];
#define HLOAD(tile_) do { TILE_DECODE(tile_); const int seqbase = r0 - ts0; \
        _Pragma("unroll") for (int i = 0; i < 5; ++i) { const int idx = tid + 512 * i, row = idx >> 4, ch = idx & 15, tt = ts0 - 8 + row; \
            hreg[i] = (u32x4){0u, 0u, 0u, 0u}; \
            if (idx < 2304 && tt >= 0 && tt < T) hreg[i] = *(const u32x4*)(P0 + (size_t)(seqbase + tt) * LDP + g * 128 + ch * 8); } } while (0)
        HLOAD(blockIdx.x >> 2);
        for (int tile_ = blockIdx.x >> 2; tile_ < tlim; tile_ += tstep) {
            TILE_DECODE(tile_);
#pragma unroll
            for (int i = 0; i < 5; ++i) { const int idx = tid + 512 * i; if (idx < 2304) *(u32x4*)(halo + (idx >> 4) * 256 + (idx & 15) * 16) = hreg[i]; }
            const size_t r = (size_t)r0 + wid * 16 + li;
            u32x2 zreg[8];
#pragma unroll
            for (int nb = 0; nb < 8; ++nb) zreg[nb] = *(const u32x2*)(P0 + r * LDP + 512 + g * 128 + nb * 16 + kq * 4);
            __syncthreads();
            { const int c2 = tid & 63, tq = tid >> 6;
              float s0 = 0.f, s1 = 0.f; const int tl0 = tq * 16;
              for (int j = tl0 - left; j <= tl0 + right; ++j) { const unsigned w = *(const unsigned*)(halo + (j + 8) * 256 + c2 * 4); s0 += bflo(w); s1 += bfhi(w); }
              for (int tl = tl0; tl < tl0 + 16; ++tl) { const int t = ts0 + tl; const int lo = max(t - left, 0), hi = min(t + right + 1, T);
                  const float inv = 1.f / (float)(hi - lo); const unsigned xw = *(const unsigned*)(halo + (tl + 8) * 256 + c2 * 4);
                  *(unsigned*)(As + swz(tl, c2 >> 2) + (c2 & 3) * 4) = cvt_pk(s0 * inv - bflo(xw), s1 * inv - bfhi(xw));
                  const unsigned wn = *(const unsigned*)(halo + (tl + 1 + right + 8) * 256 + c2 * 4), wo = *(const unsigned*)(halo + (tl - left + 8) * 256 + c2 * 4);
                  s0 += bflo(wn) - bflo(wo); s1 += bfhi(wn) - bfhi(wo); } }
            __syncthreads();
            HLOAD((tile_ + tstep < tlim) ? tile_ + tstep : tile_);
            bf16x8 af[4]; ldfrag(af, As, wid, lane);
            f32x4 acc[8];
#pragma unroll
            for (int nb = 0; nb < 8; ++nb) acc[nb] = (f32x4){0.f, 0.f, 0.f, 0.f};
            mm16<8>(acc, Bs, af, lane);
#pragma unroll
            for (int nb = 0; nb < 8; ++nb) { const int d = nb * 16 + kq * 4;
                const u32x2 za = zreg[nb]; const f32x4 ps = *(const f32x4*)(p.pool_scale + g * 128 + d);
                u32x2 o; o.x = cvt_pk(acc[nb][0] * ps[0] * silu(bflo(za.x)), acc[nb][1] * ps[1] * silu(bfhi(za.x)));
                o.y = cvt_pk(acc[nb][2] * ps[2] * silu(bflo(za.y)), acc[nb][3] * ps[3] * silu(bfhi(za.y)));
                *(u32x2*)(CAT0 + r * 1024 + g * 128 + d) = o; }
        }
#undef HLOAD
    }
    __syncthreads();
    {
        const int h = g;
        stage_tile(Bs, (const bf16_t*)(p.ws + OFF_WQT) + h * 16384, 128);
        stage_tile(B2s, (const bf16_t*)(p.ws + OFF_WKT) + h * 16384, 128);
        const int ch = tid & 15, cc = h * 128 + ch * 8;
        float cw[3][8], cb[8];
#pragma unroll
        for (int e = 0; e < 8; ++e) { cb[e] = p.conv_b[cc + e];
#pragma unroll
            for (int j = 0; j < 3; ++j) cw[j][e] = p.conv_w[j * 512 + cc + e]; }
        u32x4 creg[4][3];
#define CLOAD(tile_) do { TILE_DECODE(tile_); \
        _Pragma("unroll") for (int i = 0; i < 4; ++i) { const int tl = (tid >> 4) + 32 * i, t = ts0 + tl; const long r = (long)r0 + tl; \
            _Pragma("unroll") for (int j = 0; j < 3; ++j) { const int tt = t - 1 + j; creg[i][j] = (u32x4){0u, 0u, 0u, 0u}; \
                if (tt >= 0 && tt < T) creg[i][j] = *(const u32x4*)(P0 + (size_t)(r - 1 + j) * LDP + 1024 + cc); } } } while (0)
        CLOAD(blockIdx.x >> 2);
        for (int tile_ = blockIdx.x >> 2; tile_ < tlim; tile_ += tstep) {
            TILE_DECODE(tile_); (void)T; (void)ts0;
#pragma unroll
            for (int i = 0; i < 4; ++i) { const int tl = (tid >> 4) + 32 * i; const size_t r = (size_t)r0 + tl;
                float a[8];
#pragma unroll
                for (int e = 0; e < 8; ++e) a[e] = cb[e];
#pragma unroll
                for (int j = 0; j < 3; ++j) { const u32x4 v = creg[i][j];
                    a[0] += bflo(v.x) * cw[j][0]; a[1] += bfhi(v.x) * cw[j][1]; a[2] += bflo(v.y) * cw[j][2]; a[3] += bfhi(v.y) * cw[j][3];
                    a[4] += bflo(v.z) * cw[j][4]; a[5] += bfhi(v.z) * cw[j][5]; a[6] += bflo(v.w) * cw[j][6]; a[7] += bfhi(v.w) * cw[j][7]; }
                u32x4 w; w.x = cvt_pk(silu(a[0]), silu(a[1])); w.y = cvt_pk(silu(a[2]), silu(a[3])); w.z = cvt_pk(silu(a[4]), silu(a[5])); w.w = cvt_pk(silu(a[6]), silu(a[7]));
                *(u32x4*)(As + swz(tl, ch)) = w; *(u32x4*)(CAT0 + r * 1024 + 512 + cc) = w; }
            __syncthreads();
            CLOAD((tile_ + tstep < tlim) ? tile_ + tstep : tile_);
            bf16x8 af[4]; ldfrag(af, As, wid, lane);
            const size_t r = (size_t)r0 + wid * 16 + li;
#pragma unroll
            for (int which = 0; which < 2; ++which) {
                f32x4 acc[8];
#pragma unroll
                for (int nb = 0; nb < 8; ++nb) acc[nb] = (f32x4){0.f, 0.f, 0.f, 0.f};
                mm16<8>(acc, which ? B2s : Bs, af, lane);
                bf16_t* O = which ? K0 : Q0;
#pragma unroll
                for (int nb = 0; nb < 8; ++nb) { u32x2 o; o.x = cvt_pk(acc[nb][0], acc[nb][1]); o.y = cvt_pk(acc[nb][2], acc[nb][3]);
                    *(u32x2*)(O + r * 512 + h * 128 + nb * 16 + kq * 4) = o; }
            }
            __syncthreads();
        }
#undef CLOAD
    }
#undef TILE_DECODE
}

template <int SPLIT> __device__ __forceinline__ void scan_item(const Params& p, unsigned char* smem, const int item, const int vh) {
    constexpr int NBV = SPLIT ? 4 : 8;
    int tid = threadIdx.x; asm volatile("" : "+v"(tid));
    const int wid = tid >> 6, lane = tid & 63, li = lane & 15, kq = lane >> 4;
    bf16_t* P0 = (bf16_t*)p.ws;
    const bf16_t* Q0 = (const bf16_t*)p.out; const bf16_t* K0 = Q0 + (size_t)MTOK * 512;
    const float* GATES = (const float*)(p.ws + OFF_GATES);
    unsigned char* KP = smem; unsigned char* VT = smem + 32768; unsigned char* KT = smem + 65536; unsigned char* CS = smem + 98304;
    float* g_s = (float*)(smem + 131072); float* a_s = g_s + 128; float* M_s = a_s + 128; float* n_s = M_s + 128; float* sc = n_s + 128;
    {
        int b, h, dir, T, rb;
        if (item < 64) { b = item >> 3; h = (item >> 1) & 3; dir = item & 1; T = 4096; rb = b * 4096; }
        else { const int it = item - 64; b = it >> 3; h = (it >> 1) & 3; dir = it & 1; T = 2048; rb = NPROMPT + b * 2048; }
        const int nc = T >> 7;
        const int rfirst = dir ? rb + T - 1 : rb, rstep = dir ? -1 : 1;
        const float bgi = p.bgi[dir * 4 + h], bgf = p.bgf[dir * 4 + h];
        for (int idx = tid; idx < 2048; idx += 512) *(u32x4*)(CS + idx * 16) = (u32x4){0u, 0u, 0u, 0u};
        if (tid < 128) n_s[tid] = 0.f;
        float m_run = -1e30f;
        f32x4 Cacc[NBV];
#pragma unroll
        for (int nb = 0; nb < NBV; ++nb) Cacc[nb] = (f32x4){0.f, 0.f, 0.f, 0.f};
        const int vblk = SPLIT ? 4 * vh + (wid & 3) : wid, kh = SPLIT ? (wid >> 2) : 0;
        const int sp = tid & 31, ch = tid >> 5;
        u32x4 kreg[4], vreg[4]; bf16x8 qf[4];
#define SCAN_LOAD(j) do { \
        _Pragma("unroll") for (int i = 0; i < 4; ++i) { const size_t r = (size_t)(rfirst + rstep * ((j) * 128 + sp * 4 + i)); \
            kreg[i] = *(const u32x4*)(K0 + r * 512 + h * 128 + ch * 8); vreg[i] = *(const u32x4*)(P0 + r * LDP + 1536 + h * 128 + ch * 8); } \
        } while (0)
#define Q_LOAD(j) do { const size_t r = (size_t)(rfirst + rstep * ((j) * 128 + wid * 16 + li)); \
          _Pragma("unroll") for (int ks = 0; ks < 4; ++ks) qf[ks] = *(const bf16x8*)(Q0 + r * 512 + h * 128 + ks * 32 + kq * 8); } while (0)
#define GATE_LOAD(j) do { pg = *(const float2*)(scr + (j) * 384 + 2 * lane); pa = *(const float2*)(scr + (j) * 384 + 128 + 2 * lane); \
        ppm = *(const float2*)(scr + (j) * 384 + 256 + 2 * lane); pG = scr[32 * 384 + (j)]; pPM = scr[32 * 384 + 32 + (j)]; } while (0)
        float* scr = (float*)(p.ws + OFF_SCR) + (size_t)item * SCR_ITEM;
        for (int j = wid; j < nc; j += 8) {
            const size_t ra = (size_t)(rfirst + rstep * (j * 128 + 2 * lane)), rc = (size_t)(rfirst + rstep * (j * 128 + 2 * lane + 1));
            const float ig0 = GATES[ra * 16 + dir * 4 + h] + bgi, ig1 = GATES[rc * 16 + dir * 4 + h] + bgi;
            const float x0 = GATES[ra * 16 + 8 + dir * 4 + h] + bgf, x1 = GATES[rc * 16 + 8 + dir * 4 + h] + bgf;
            const float lf0 = fminf(x0, 0.f) - log1pf(expf(-fabsf(x0))), lf1 = fminf(x1, 0.f) - log1pf(expf(-fabsf(x1)));
            float ps = lf0 + lf1;
#pragma unroll
            for (int off = 1; off < 64; off <<= 1) { const float v = __shfl_up(ps, off); if (lane >= off) ps += v; }
            float ex = __shfl_up(ps, 1); if (lane == 0) ex = 0.f;
            const float g0 = ex + lf0, g1 = g0 + lf1;
            const float a0 = ig0 - g0, a1 = ig1 - g1;
            float pm = fmaxf(a0, a1);
#pragma unroll
            for (int off = 1; off < 64; off <<= 1) { const float v = __shfl_up(pm, off); if (lane >= off) pm = fmaxf(pm, v); }
            float pe = __shfl_up(pm, 1); if (lane == 0) pe = -3.0e38f;
            const float pm0 = fmaxf(pe, a0), pm1 = fmaxf(pm0, a1);
            float* cj = scr + j * 384;
            *(float2*)(cj + 2 * lane) = make_float2(g0, g1); *(float2*)(cj + 128 + 2 * lane) = make_float2(a0, a1); *(float2*)(cj + 256 + 2 * lane) = make_float2(pm0, pm1);
            if (lane == 63) { scr[32 * 384 + j] = g1; scr[32 * 384 + 32 + j] = pm1; }
        }
        __builtin_amdgcn_fence(__ATOMIC_SEQ_CST, "workgroup"); __syncthreads();
        float2 pg = make_float2(0.f, 0.f), pa = pg, ppm = pg; float pG = 0.f, pPM = 0.f;
        SCAN_LOAD(0); Q_LOAD(0);
        if (wid == 0) GATE_LOAD(0);
        for (int j = 0; j < nc; ++j) {
            const int jn = (j + 1 < nc) ? j + 1 : j;
            if (wid == 0) {
                const float M127 = fmaxf(m_run, pPM);
                g_s[2 * lane] = pg.x; g_s[2 * lane + 1] = pg.y; a_s[2 * lane] = pa.x; a_s[2 * lane + 1] = pa.y;
                M_s[2 * lane] = fmaxf(m_run, ppm.x); M_s[2 * lane + 1] = fmaxf(m_run, ppm.y);
                if (lane == 0) { sc[0] = m_run; sc[1] = M127; }
                m_run = pG + M127;
                GATE_LOAD(jn);
            }
            __syncthreads();
            const float m_old = sc[0], M127 = sc[1];
            const float decay = __expf(m_old - M127);
            {
                const f32x4 a4 = *(const f32x4*)(a_s + sp * 4);
                float wsv[4];
#pragma unroll
                for (int i = 0; i < 4; ++i) wsv[i] = __expf(a4[i] - M127);
#pragma unroll
                for (int i = 0; i < 4; ++i) { const u32x4 k = kreg[i]; u32x4 w;
                    w.x = cvt_pk(bflo(k.x) * wsv[i], bfhi(k.x) * wsv[i]); w.y = cvt_pk(bflo(k.y) * wsv[i], bfhi(k.y) * wsv[i]);
                    w.z = cvt_pk(bflo(k.z) * wsv[i], bfhi(k.z) * wsv[i]); w.w = cvt_pk(bflo(k.w) * wsv[i], bfhi(k.w) * wsv[i]);
                    *(u32x4*)(KP + swz(sp * 4 + i, ch)) = w; }
#pragma unroll
                for (int e2 = 0; e2 < 4; ++e2) {
                    const unsigned k0 = kreg[0][e2], k1 = kreg[1][e2], k2 = kreg[2][e2], k3 = kreg[3][e2];
                    const unsigned v0 = vreg[0][e2], v1 = vreg[1][e2], v2 = vreg[2][e2], v3 = vreg[3][e2];
                    const int d0 = ch * 8 + 2 * e2, d1 = d0 + 1; const int co = (sp & 1) * 8;
                    u32x2 o;
                    o.x = cvt_pk(bflo(k0) * wsv[0], bflo(k1) * wsv[1]); o.y = cvt_pk(bflo(k2) * wsv[2], bflo(k3) * wsv[3]);
                    *(u32x2*)(KT + swz(d0, sp >> 1) + co) = o;
                    o.x = cvt_pk(bfhi(k0) * wsv[0], bfhi(k1) * wsv[1]); o.y = cvt_pk(bfhi(k2) * wsv[2], bfhi(k3) * wsv[3]);
                    *(u32x2*)(KT + swz(d1, sp >> 1) + co) = o;
                    o.x = (v0 & 0xffffu) | (v1 << 16); o.y = (v2 & 0xffffu) | (v3 << 16);
                    *(u32x2*)(VT + swz(d0, sp >> 1) + co) = o;
                    o.x = (v0 >> 16) | (v1 & 0xffff0000u); o.y = (v2 >> 16) | (v3 & 0xffff0000u);
                    *(u32x2*)(VT + swz(d1, sp >> 1) + co) = o;
                }
            }
            const size_t rowl = (size_t)(rfirst + rstep * (j * 128 + wid * 16 + li));
            __syncthreads();
            SCAN_LOAD(jn);
            __builtin_amdgcn_sched_barrier(0);
            const int l = wid * 16 + li;
            const float Ml = M_s[l], gl = g_s[l];
            f32x4 acc[8];
#pragma unroll
            for (int nb = 0; nb < 8; ++nb) acc[nb] = (f32x4){0.f, 0.f, 0.f, 0.f};
            mm16<8>(acc, KP, qf, lane);
            __builtin_amdgcn_sched_barrier(0);
            float rs = 0.f; u32x2 pp[8];
            const float rowf = __expf(fminf(sc[1] - Ml, 80.f));
            const int widu = __builtin_amdgcn_readfirstlane(wid);
#pragma unroll
            for (int nb = 0; nb < 8; ++nb) {
                if (nb < widu) { const f32x4 pv = acc[nb]; rs += (pv[0] + pv[1]) + (pv[2] + pv[3]); pp[nb].x = cvt_pk(pv[0], pv[1]); pp[nb].y = cvt_pk(pv[2], pv[3]); }
                else if (nb == widu) { float pv[4];
#pragma unroll
                    for (int jj = 0; jj < 4; ++jj) { const int s = nb * 16 + kq * 4 + jj; pv[jj] = (s <= l) ? acc[nb][jj] : 0.f; rs += pv[jj]; }
                    pp[nb].x = cvt_pk(pv[0], pv[1]); pp[nb].y = cvt_pk(pv[2], pv[3]); }
                else { pp[nb].x = 0u; pp[nb].y = 0u; } }
            __builtin_amdgcn_sched_barrier(0);
            float nq = 0.f;
#pragma unroll
            for (int ks = 0; ks < 4; ++ks) { const f32x4 n0 = *(const f32x4*)(n_s + ks * 32 + kq * 8), n1 = *(const f32x4*)(n_s + ks * 32 + kq * 8 + 4);
                const u32x4 qw = *(const u32x4*)&qf[ks];
                nq += bflo(qw.x) * n0[0] + bfhi(qw.x) * n0[1] + bflo(qw.y) * n0[2] + bfhi(qw.y) * n0[3] + bflo(qw.z) * n1[0] + bfhi(qw.z) * n1[1] + bflo(qw.w) * n1[2] + bfhi(qw.w) * n1[3]; }
            rs += __shfl_xor(rs, 16); rs += __shfl_xor(rs, 32); nq += __shfl_xor(nq, 16); nq += __shfl_xor(nq, 32);
            const float exl = __expf(m_old - Ml);
            const float den = rowf * rs + exl * nq;
            const float hinv = rowf * __frcp_rn(fmaxf(fabsf(den), __expf(-(gl + Ml))));
            __syncthreads();
#pragma unroll
            for (int nb = 0; nb < 8; ++nb) *(u32x2*)(KP + swz(l, nb * 2 + (kq >> 1)) + (kq & 1) * 8) = pp[nb];
            f32x4 acc2[NBV];
#pragma unroll
            for (int nb = 0; nb < NBV; ++nb) acc2[nb] = (f32x4){0.f, 0.f, 0.f, 0.f};
            __builtin_amdgcn_sched_barrier(0);
            mm16<NBV>(acc2, CS + vh * 16384, qf, lane);
            __builtin_amdgcn_sched_barrier(0);
            Q_LOAD(jn);
#pragma unroll
            for (int nb = 0; nb < NBV; ++nb) acc2[nb] *= decay;
            __builtin_amdgcn_sched_barrier(0);
            { bf16x8 pf[4]; ldfrag(pf, KP, wid, lane); mm16<NBV>(acc2, VT + vh * 16384, pf, lane); }
            __builtin_amdgcn_sched_barrier(0);
            { bf16_t* hp = P0 + rowl * LDP + dir * 512 + h * 128 + vh * 64 + kq * 4;
#pragma unroll
              for (int nb = 0; nb < NBV; ++nb) { u32x2 o; o.x = cvt_pk(acc2[nb][0] * hinv, acc2[nb][1] * hinv); o.y = cvt_pk(acc2[nb][2] * hinv, acc2[nb][3] * hinv);
                  *(u32x2*)(hp + nb * 16) = o; } }
            __builtin_amdgcn_sched_barrier(0);
            float nnew;
            { bf16x8 vf[4]; ldfrag(vf, VT, vblk, lane);
#pragma unroll
              for (int nb = 0; nb < NBV; ++nb) Cacc[nb] *= decay;
              mm16<NBV>(Cacc, KT + kh * 16384, vf, lane);
              float part = 0.f;
#pragma unroll
              for (int ks = 0; ks < 4; ++ks) { const u32x4 kw = *(const u32x4*)(KT + swz(wid * 16 + li, ks * 4 + kq));
                  part += bflo(kw.x) + bfhi(kw.x) + bflo(kw.y) + bfhi(kw.y) + bflo(kw.z) + bfhi(kw.z) + bflo(kw.w) + bfhi(kw.w); }
              part += __shfl_xor(part, 16); part += __shfl_xor(part, 32);
              nnew = decay * n_s[wid * 16 + li] + part; }
            __syncthreads();
#pragma unroll
            for (int nb = 0; nb < NBV; ++nb) { u32x2 o; o.x = cvt_pk(Cacc[nb][0], Cacc[nb][1]); o.y = cvt_pk(Cacc[nb][2], Cacc[nb][3]);
                *(u32x2*)(CS + swz(vblk * 16 + li, (kh * 4 + nb) * 2 + (kq >> 1)) + (kq & 1) * 8) = o; }
            if (kq == 0) n_s[wid * 16 + li] = nnew;
        }
        __syncthreads();
#undef SCAN_LOAD
#undef Q_LOAD
#undef GATE_LOAD
    }
}
__device__ void phase_scan(const Params& p, unsigned char* smem) {
    for (int rep_ = 0; rep_ < (REP_PH == 3 ? 2 : 1); ++rep_) {
        const int c = blockIdx.x;
        if (c < 128) scan_item<1>(p, smem, c >> 1, c & 1); else scan_item<0>(p, smem, 64 + (c - 128), 0);
    }
}

__device__ void panel_outb(const Params& p, int r0) {
    const int wid = threadIdx.x >> 6, lane = threadIdx.x & 63, col = (lane >> 4) * 128 + (lane & 15) * 8;
    const bf16_t* P0 = (const bf16_t*)p.ws; bf16_t* CAT0 = (bf16_t*)p.out + (size_t)MTOK * 1024;
    float gg[8], sk[8];
#pragma unroll
    for (int e = 0; e < 8; ++e) { gg[e] = p.mh_g[col + e]; sk[e] = p.skip[col + e]; }
    u32x4 pre[5];
#define OB_LOAD(it) do { const size_t r_ = (size_t)r0 + (it) * 8 + wid; const bf16_t* pr_ = P0 + r_ * LDP; \
        pre[0] = *(const u32x4*)(pr_ + col); pre[1] = *(const u32x4*)(pr_ + 512 + col); pre[2] = *(const u32x4*)(pr_ + 2048 + col); pre[3] = *(const u32x4*)(pr_ + 2560 + col); \
        pre[4] = *(const u32x4*)(CAT0 + r_ * 1024 + 512 + col); } while (0)
    OB_LOAD(0);
    for (int it = 0; it < 32; ++it) {
        const size_t r = (size_t)r0 + it * 8 + wid;
        const u32x4 hf = pre[0], hb = pre[1], ob = pre[2], zb = pre[3], xc = pre[4];
        OB_LOAD((it + 1 < 32) ? it + 1 : it);
        float hv[8], o[8], z[8], x[8];
#pragma unroll
        for (int w = 0; w < 4; ++w) { hv[2 * w] = bflo(hf[w]) + bflo(hb[w]); hv[2 * w + 1] = bfhi(hf[w]) + bfhi(hb[w]); o[2 * w] = bflo(ob[w]); o[2 * w + 1] = bfhi(ob[w]);
            z[2 * w] = bflo(zb[w]); z[2 * w + 1] = bfhi(zb[w]); x[2 * w] = bflo(xc[w]); x[2 * w + 1] = bfhi(xc[w]); }
        float s = 0.f;
#pragma unroll
        for (int e = 0; e < 8; ++e) { hv[e] *= sigm(o[e]); s += hv[e]; }
        s += __shfl_xor(s, 1); s += __shfl_xor(s, 2); s += __shfl_xor(s, 4); s += __shfl_xor(s, 8);
        const float mu = s * (1.f / 128.f); float v = 0.f;
#pragma unroll
        for (int e = 0; e < 8; ++e) { hv[e] -= mu; v += hv[e] * hv[e]; }
        v += __shfl_xor(v, 1); v += __shfl_xor(v, 2); v += __shfl_xor(v, 4); v += __shfl_xor(v, 8);
        const float rstd = rsqrtf(v * (1.f / 128.f) + 1e-5f);
        float ov[8];
#pragma unroll
        for (int e = 0; e < 8; ++e) ov[e] = (hv[e] * rstd * gg[e] + sk[e] * x[e]) * silu(z[e]);
        u32x4 w; w.x = cvt_pk(ov[0], ov[1]); w.y = cvt_pk(ov[2], ov[3]); w.z = cvt_pk(ov[4], ov[5]); w.w = cvt_pk(ov[6], ov[7]);
        *(u32x4*)(CAT0 + r * 1024 + 512 + col) = w;
    }
#undef OB_LOAD
}
template <int OUT_F32> __device__ void panel_ln(const bf16_t* Y, const float* xp, const float* xs, const float* g, const float* b, void* dst, int r0) {
    const int wid = threadIdx.x >> 6, lane = threadIdx.x & 63;
    u32x4 wy[2]; f32x4 wx[2][2];
#define LN_LOAD(it) do { const size_t r_ = (size_t)r0 + (it) * 8 + wid; const bf16_t* y_ = Y + r_ * LDP; \
        _Pragma("unroll") for (int i = 0; i < 2; ++i) { const int c_ = i * 512 + lane * 8; wy[i] = *(const u32x4*)(y_ + c_); \
            if (!OUT_F32) { const float* src_ = (r_ < NPROMPT ? xp + r_ * 1024 : xs + (r_ - NPROMPT) * 1024) + c_; wx[i][0] = __builtin_nontemporal_load((const f32x4*)src_); wx[i][1] = __builtin_nontemporal_load((const f32x4*)(src_ + 4)); } } } while (0)
    LN_LOAD(0);
    for (int it = 0; it < 32; ++it) {
        const size_t r = (size_t)r0 + it * 8 + wid;
        float v[2][8]; float s = 0.f;
#pragma unroll
        for (int i = 0; i < 2; ++i) { const u32x4 w = wy[i];
            v[i][0] = bflo(w.x); v[i][1] = bfhi(w.x); v[i][2] = bflo(w.y); v[i][3] = bfhi(w.y); v[i][4] = bflo(w.z); v[i][5] = bfhi(w.z); v[i][6] = bflo(w.w); v[i][7] = bfhi(w.w);
            if (!OUT_F32) {
#pragma unroll
                for (int e = 0; e < 4; ++e) { v[i][e] += wx[i][0][e] * ALPHA; v[i][4 + e] += wx[i][1][e] * ALPHA; } }
#pragma unroll
            for (int e = 0; e < 8; ++e) s += v[i][e]; }
        LN_LOAD((it + 1 < 32) ? it + 1 : it);
#pragma unroll
        for (int off = 1; off < 64; off <<= 1) s += __shfl_xor(s, off);
        const float mu = s * (1.f / 1024.f); float q = 0.f;
#pragma unroll
        for (int i = 0; i < 2; ++i)
#pragma unroll
            for (int e = 0; e < 8; ++e) { v[i][e] -= mu; q += v[i][e] * v[i][e]; }
#pragma unroll
        for (int off = 1; off < 64; off <<= 1) q += __shfl_xor(q, off);
        const float rstd = rsqrtf(q * (1.f / 1024.f) + 1e-5f);
#pragma unroll
        for (int i = 0; i < 2; ++i) { const int c = i * 512 + lane * 8; const f32x4 g0 = *(const f32x4*)(g + c), g1 = *(const f32x4*)(g + c + 4), b0 = *(const f32x4*)(b + c), b1 = *(const f32x4*)(b + c + 4);
            f32x4 o0, o1;
#pragma unroll
            for (int e = 0; e < 4; ++e) { o0[e] = v[i][e] * rstd * g0[e] + b0[e]; o1[e] = v[i][4 + e] * rstd * g1[e] + b1[e]; }
            if (OUT_F32) { __builtin_nontemporal_store(o0, (f32x4*)((float*)dst + r * 1024 + c)); __builtin_nontemporal_store(o1, (f32x4*)((float*)dst + r * 1024 + c + 4)); }
            else { u32x4 w; w.x = cvt_pk(o0[0], o0[1]); w.y = cvt_pk(o0[2], o0[3]); w.z = cvt_pk(o1[0], o1[1]); w.w = cvt_pk(o1[2], o1[3]); *(u32x4*)((bf16_t*)dst + r * 1024 + c) = w; } }
    }
#undef LN_LOAD
}
__device__ void panel_qknorm(const Params& p, int r0) {
    const int wid = threadIdx.x >> 6, lane = threadIdx.x & 63, sub = lane >> 4, l16 = lane & 15;
    bf16_t* P1 = (bf16_t*)p.ws;
    const int axis = l16 >> 3, f0 = (l16 & 7) * 4, d1 = axis * 64 + f0, d2 = d1 + 32;
    float inv[4];
#pragma unroll
    for (int e = 0; e < 4; ++e) inv[e] = exp2f(-(float)(f0 + e) * (13.287712379549449f / 32.f));
    for (int u = wid * 4 + sub; u < 512; u += 32) {
        const int rl = u >> 1, hh = 8 + (u & 1); const size_t r = (size_t)r0 + rl;
        const int t = (r < NPROMPT) ? (int)(r & 4095) : (int)((r - NPROMPT) & 2047);
        const float pos = (float)(axis ? (t & 63) : (t >> 6));
        bf16_t* base = P1 + r * LDP + (hh < 8 ? hh * 128 : 1024 + (hh - 8) * 128);
        const float* gn = hh < 8 ? p.qng : p.kng;
        const u32x2 w1 = *(const u32x2*)(base + d1), w2 = *(const u32x2*)(base + d2);
        float x1[4] = {bflo(w1.x), bfhi(w1.x), bflo(w1.y), bfhi(w1.y)}, x2[4] = {bflo(w2.x), bfhi(w2.x), bflo(w2.y), bfhi(w2.y)};
        float ss = 0.f;
#pragma unroll
        for (int e = 0; e < 4; ++e) ss += x1[e] * x1[e] + x2[e] * x2[e];
        ss += __shfl_xor(ss, 1); ss += __shfl_xor(ss, 2); ss += __shfl_xor(ss, 4); ss += __shfl_xor(ss, 8);
        const float rinv = rsqrtf(ss * (1.f / 128.f) + 1e-6f);
        const f32x4 g1 = *(const f32x4*)(gn + d1), g2 = *(const f32x4*)(gn + d2);
        float o1[4], o2[4];
#pragma unroll
        for (int e = 0; e < 4; ++e) { const float a = x1[e] * rinv * g1[e], bb = x2[e] * rinv * g2[e];
            const float ang = pos * inv[e]; float sn, cs; __sincosf(ang, &sn, &cs);
            o1[e] = a * cs - bb * sn; o2[e] = bb * cs + a * sn; }
        u32x2 q1, q2; q1.x = cvt_pk(o1[0], o1[1]); q1.y = cvt_pk(o1[2], o1[3]); q2.x = cvt_pk(o2[0], o2[1]); q2.y = cvt_pk(o2[2], o2[3]);
        *(u32x2*)(base + d1) = q1; *(u32x2*)(base + d2) = q2;
    }
}

namespace att {
constexpr int D = 128, NW = 8, QBLK = 32, KVBLK = 64;
constexpr float SCALE = 0.088388347648318440f, THR = 8.f;
constexpr size_t SHM_V = KVBLK * D * 2, SHM_K = KVBLK * D * 2;
#define KSWZ(row, colB) ((row) * 256 + ((colB) ^ (((row) & 15) << 4)))
#define SBAR() __builtin_amdgcn_sched_barrier(0)
__device__ __forceinline__ int crow(int r, int hi) { return (r & 3) + 8 * (r >> 2) + 4 * hi; }
__device__ __forceinline__ void partialSM(f32x16& p0, f32x16& p1, float shift) {
    if (shift != 0.f) { for (int r = 0; r < 16; ++r) { p0[r] += shift; p1[r] += shift; } }
    for (int r = 0; r < 16; ++r) p0[r] = __builtin_amdgcn_exp2f(p0[r]);
}
__device__ __forceinline__ void finishSM(f32x16& p0, f32x16& p1, float alpha, float& l_reg, bf16x8& pa0, bf16x8& pa1, bf16x8& pa2, bf16x8& pa3) {
    for (int r = 0; r < 16; ++r) p1[r] = __builtin_amdgcn_exp2f(p1[r]);
    float ps = 0; for (int r = 0; r < 16; ++r) ps += p0[r]; for (int r = 0; r < 16; ++r) ps += p1[r];
    { auto rr = __builtin_amdgcn_permlane32_swap(__float_as_uint(ps), __float_as_uint(ps), false, false);
      ps = __uint_as_float(rr[0]) + __uint_as_float(rr[1]); }
    l_reg = l_reg * alpha + ps;
#define PK4(P, BASE, OUT) do { unsigned a0 = cvt_pk(P[BASE + 0], P[BASE + 1]), a1 = cvt_pk(P[BASE + 2], P[BASE + 3]);   \
    unsigned b0 = cvt_pk(P[BASE + 4], P[BASE + 5]), b1 = cvt_pk(P[BASE + 6], P[BASE + 7]);                              \
    auto r0 = __builtin_amdgcn_permlane32_swap(a0, b0, false, false); auto r1 = __builtin_amdgcn_permlane32_swap(a1, b1, false, false); \
    u32x4 w = {r0[0], r1[0], r0[1], r1[1]}; OUT = *reinterpret_cast<bf16x8*>(&w); } while (0)
    PK4(p0, 0, pa0); PK4(p0, 8, pa1); PK4(p1, 0, pa2); PK4(p1, 8, pa3);
#undef PK4
}
__device__ __forceinline__ void qkt(f32x16& p0, f32x16& p1, const bf16_t* Ks, const bf16x8* qr, int r32, int hi) {
    p0 = f32x16{}; p1 = f32x16{};
    for (int d0 = 0; d0 < 8; ++d0) { int cb = (d0 * 16 + hi * 8) * 2;
        bf16x8 b0 = *reinterpret_cast<const bf16x8*>((const char*)Ks + KSWZ(r32, cb));
        bf16x8 b1 = *reinterpret_cast<const bf16x8*>((const char*)Ks + KSWZ(32 + r32, cb));
        p0 = __builtin_amdgcn_mfma_f32_32x32x16_bf16(b0, qr[d0], p0, 0, 0, 0);
        p1 = __builtin_amdgcn_mfma_f32_32x32x16_bf16(b1, qr[d0], p1, 0, 0, 0); }
}
__device__ __forceinline__ int v_st(int k, int c) { const int kk = (k & ~0xC) | ((k & 4) << 1) | ((k & 8) >> 1); return ((kk >> 3) * 4 + (c >> 5)) * 512 + ((kk & 7) * 32 + (c & 31)) * 2; }
__device__ __forceinline__ int v_rd_base(int lane) { return ((lane & 3) << 3) | (((lane >> 2) & 3) << 6) | (((lane >> 4) & 1) << 5) | (((lane >> 5) & 1) << 8); }
constexpr int v_rd_off(int d0, int ks, int half) { return d0 * 512 + ks * 4096 + half * 2048; }
template <int OFF> __device__ __forceinline__ s16x4 tr_read(int vb) {
    s16x4 r; asm volatile("ds_read_b64_tr_b16 %0, %1 offset:%2" : "=&v"(r) : "v"(vb), "i"(OFF) : "memory"); return r;
}
template <int D0> __device__ __forceinline__ void pv_one(f32x16& od, int vb, bf16x8 pa0, bf16x8 pa1, bf16x8 pa2, bf16x8 pa3) {
    const s16x4 l0 = tr_read<v_rd_off(D0, 0, 0)>(vb), h0 = tr_read<v_rd_off(D0, 0, 1)>(vb), l1 = tr_read<v_rd_off(D0, 1, 0)>(vb), h1 = tr_read<v_rd_off(D0, 1, 1)>(vb);
    const s16x4 l2 = tr_read<v_rd_off(D0, 2, 0)>(vb), h2 = tr_read<v_rd_off(D0, 2, 1)>(vb), l3 = tr_read<v_rd_off(D0, 3, 0)>(vb), h3 = tr_read<v_rd_off(D0, 3, 1)>(vb);
    asm volatile("s_waitcnt lgkmcnt(0)" ::: "memory"); SBAR();
#define PK(L, H) (bf16x8){L[0], L[1], L[2], L[3], H[0], H[1], H[2], H[3]}
    od = __builtin_amdgcn_mfma_f32_32x32x16_bf16(pa0, PK(l0, h0), od, 0, 0, 0);
    od = __builtin_amdgcn_mfma_f32_32x32x16_bf16(pa1, PK(l1, h1), od, 0, 0, 0);
    od = __builtin_amdgcn_mfma_f32_32x32x16_bf16(pa2, PK(l2, h2), od, 0, 0, 0);
    od = __builtin_amdgcn_mfma_f32_32x32x16_bf16(pa3, PK(l3, h3), od, 0, 0, 0);
#undef PK
}
__device__ __forceinline__ void pv_d0(f32x16* o, int vb, bf16x8 pa0, bf16x8 pa1, bf16x8 pa2, bf16x8 pa3) {
    pv_one<0>(o[0], vb, pa0, pa1, pa2, pa3); pv_one<1>(o[1], vb, pa0, pa1, pa2, pa3); pv_one<2>(o[2], vb, pa0, pa1, pa2, pa3); pv_one<3>(o[3], vb, pa0, pa1, pa2, pa3);
}
__device__ __forceinline__ void attn_body(const bf16_t* __restrict__ Qb, const bf16_t* __restrict__ Kh, const bf16_t* __restrict__ Vh, const bf16_t* __restrict__ Zb,
                                          bf16_t* __restrict__ Ob, int seq, char* lds, int tq0, const float* __restrict__ qg, const float* __restrict__ rope, float negBC) {
    constexpr int LDQ = LDP, LDK = LDP;
    int tid = threadIdx.x; asm volatile("" : "+v"(tid));
    const int wid = tid >> 6, lane = tid & 63, r32 = lane & 31, hi = lane >> 5;
    bf16_t* V_lds = (bf16_t*)lds; bf16_t* K_lds = (bf16_t*)(lds + 2 * SHM_V);
    float* ws = (float*)(lds + 2 * SHM_V + 2 * SHM_K) + wid * 64; float* li_l = ws; float* al_l = ws + 32;
    float l_reg = 0; f32x16 o[4] = {}; bf16x8 qr[8];
    const bf16_t* Qw = Qb + (long)(wid * QBLK + r32) * LDQ + hi * 8;
#pragma unroll
    for (int d0 = 0; d0 < 8; ++d0) qr[d0] = *reinterpret_cast<const bf16x8*>(Qw + d0 * 16);
    const int sr = tid >> 4, sc = (tid & 15) * 8, vst0 = v_st(sr, sc), vst1 = v_st(32 + sr, sc);
    const int vb0 = (int)(uintptr_t)V_lds + v_rd_base(lane);
    struct { bf16x8 vs0, vs1, ks0, ks1; } sr_[2];
#define LD8(P) (*reinterpret_cast<const bf16x8*>(P))
#define SLOAD(i, k0) do { sr_[i].vs0 = LD8(&Vh[(long)((k0) + sr) * LDK + sc]); sr_[i].vs1 = LD8(&Vh[(long)((k0) + 32 + sr) * LDK + sc]); \
    sr_[i].ks0 = LD8(&Kh[(long)((k0) + sr) * LDK + sc]); sr_[i].ks1 = LD8(&Kh[(long)((k0) + 32 + sr) * LDK + sc]); } while (0)
    SLOAD(0, 0); SLOAD(1, KVBLK);
    {
        float ss = 0.f; int hi_ = hi; const float* qg_ = qg;
        asm volatile("" : "+v"(hi_)); asm volatile("" : "+s"(qg_));
#pragma unroll
        for (int d0 = 0; d0 < 8; ++d0) { const u32x4 w = *reinterpret_cast<const u32x4*>(&qr[d0]);
            ss += bflo(w.x) * bflo(w.x) + bfhi(w.x) * bfhi(w.x) + bflo(w.y) * bflo(w.y) + bfhi(w.y) * bfhi(w.y) + bflo(w.z) * bflo(w.z) + bfhi(w.z) * bfhi(w.z) + bflo(w.w) * bflo(w.w) + bfhi(w.w) * bfhi(w.w); }
        ss += __shfl_xor(ss, 32);
        const float rinv = rsqrtf(ss * (1.f / 128.f) + 1e-6f) * (SCALE * 1.4426950408889634f);
        const int tpos = tq0 + wid * QBLK + r32; const float* rope_ = rope; asm volatile("" : "+s"(rope_));
#pragma unroll
        for (int ax = 0; ax < 2; ++ax)
#pragma unroll
            for (int dd = 0; dd < 2; ++dd) { const int da = ax * 4 + dd, db = da + 2;
                const u32x4 wa = *reinterpret_cast<const u32x4*>(&qr[da]), wb = *reinterpret_cast<const u32x4*>(&qr[db]);
                float xa[8] = {bflo(wa.x), bfhi(wa.x), bflo(wa.y), bfhi(wa.y), bflo(wa.z), bfhi(wa.z), bflo(wa.w), bfhi(wa.w)};
                float xb[8] = {bflo(wb.x), bfhi(wb.x), bflo(wb.y), bfhi(wb.y), bflo(wb.z), bfhi(wb.z), bflo(wb.w), bfhi(wb.w)};
                const float* ga = qg_ + da * 16 + hi_ * 8; const float* gb = qg_ + db * 16 + hi_ * 8;
                const f32x4* tp = (const f32x4*)(rope_ + ((ax ? (tpos & 63) : (tpos >> 6)) * 32 + dd * 16 + hi_ * 8) * 2);
                const f32x4 t0 = tp[0], t1 = tp[1], t2 = tp[2], t3 = tp[3];
                const float csv[8] = {t0[0], t0[2], t1[0], t1[2], t2[0], t2[2], t3[0], t3[2]}, snv[8] = {t0[1], t0[3], t1[1], t1[3], t2[1], t2[3], t3[1], t3[3]};
#pragma unroll
                for (int e = 0; e < 8; ++e) { const float x1 = xa[e] * rinv * ga[e], x2 = xb[e] * rinv * gb[e];
                    xa[e] = x1 * csv[e] - x2 * snv[e]; xb[e] = x2 * csv[e] + x1 * snv[e]; }
                u32x4 oa, ob; oa.x = cvt_pk(xa[0], xa[1]); oa.y = cvt_pk(xa[2], xa[3]); oa.z = cvt_pk(xa[4], xa[5]); oa.w = cvt_pk(xa[6], xa[7]);
                ob.x = cvt_pk(xb[0], xb[1]); ob.y = cvt_pk(xb[2], xb[3]); ob.z = cvt_pk(xb[4], xb[5]); ob.w = cvt_pk(xb[6], xb[7]);
                qr[da] = *reinterpret_cast<bf16x8*>(&oa); qr[db] = *reinterpret_cast<bf16x8*>(&ob);
                __builtin_amdgcn_sched_barrier(0); }
    }
#define SWRITE(b, i) do { *(bf16x8*)((char*)V_lds + (b) * SHM_V + vst0) = sr_[i].vs0;          \
    *(bf16x8*)((char*)V_lds + (b) * SHM_V + vst1) = sr_[i].vs1; int kc = sc * 2;               \
    *(bf16x8*)((char*)K_lds + (b) * SHM_K + KSWZ(sr, kc)) = sr_[i].ks0;                       \
    *(bf16x8*)((char*)K_lds + (b) * SHM_K + KSWZ(32 + sr, kc)) = sr_[i].ks1; } while (0)
#define SWAIT() asm volatile("s_waitcnt vmcnt(4)" ::: "memory")
#define RESC(a) do { if (__any((a) < 1.f)) { if (hi == 0) al_l[r32] = (a); asm volatile("s_waitcnt lgkmcnt(0)" ::: "memory"); \
    for (int d = 0; d < 4; ++d) for (int r = 0; r < 16; ++r) o[d][r] *= al_l[crow(r, hi)]; } } while (0)
    f32x16 pA0, pA1, pB0, pB1; bf16x8 pa0, pa1, pa2, pa3; const int NT = seq / KVBLK;
    constexpr int SE = 0, SO = 1;
    asm volatile("s_waitcnt vmcnt(0)" ::: "memory"); SWRITE(0, SE); __syncthreads();
    qkt(pA0, pA1, K_lds, qr, r32, hi); partialSM(pA0, pA1, negBC);
    SLOAD(SE, 2 * KVBLK);
    SWAIT(); SWRITE(1, SO); __syncthreads();
    if (__builtin_amdgcn_readfirstlane(tid) >= 256) __builtin_amdgcn_s_setprio(1);
    for (int j = 1; j + 1 < NT; j += 2) {
        SBAR(); qkt(pB0, pB1, (bf16_t*)((char*)K_lds + SHM_K), qr, r32, hi);
        finishSM(pA0, pA1, 1.f, l_reg, pa0, pa1, pa2, pa3); SBAR();
        SLOAD(SO, (j + 2) * KVBLK); SBAR();
        pv_d0(o, vb0, pa0, pa1, pa2, pa3); partialSM(pB0, pB1, negBC);
        __syncthreads(); SWAIT(); SWRITE(0, SE);
        __syncthreads();
        SBAR(); qkt(pA0, pA1, K_lds, qr, r32, hi);
        finishSM(pB0, pB1, 1.f, l_reg, pa0, pa1, pa2, pa3); SBAR();
        SLOAD(SE, ((j + 3 < NT) ? (j + 3) : (NT - 1)) * KVBLK); SBAR();
        pv_d0(o, vb0 + (int)SHM_V, pa0, pa1, pa2, pa3); partialSM(pA0, pA1, negBC);
        __syncthreads(); SWAIT(); SWRITE(1, SO);
        __syncthreads();
    }
    SBAR(); qkt(pB0, pB1, (bf16_t*)((char*)K_lds + SHM_K), qr, r32, hi);
    finishSM(pA0, pA1, 1.f, l_reg, pa0, pa1, pa2, pa3); SBAR();
    pv_d0(o, vb0, pa0, pa1, pa2, pa3); partialSM(pB0, pB1, negBC);
    __syncthreads();
    finishSM(pB0, pB1, 1.f, l_reg, pa0, pa1, pa2, pa3); SBAR();
    pv_d0(o, vb0 + (int)SHM_V, pa0, pa1, pa2, pa3);
    __builtin_amdgcn_s_setprio(0);
    if (hi == 0) li_l[r32] = l_reg; asm volatile("s_waitcnt lgkmcnt(0)" ::: "memory");
    float rli[16];
#pragma unroll
    for (int r = 0; r < 16; ++r) rli[r] = __builtin_amdgcn_rcpf(li_l[crow(r, hi)]);
    u32x4 zr[8];
#pragma unroll
    for (int i = 0; i < 8; ++i) { const int idx = tid + 512 * i; zr[i] = *(const u32x4*)(Zb + (long)(idx >> 4) * LDP + (idx & 15) * 8); }
    __syncthreads();
    float* Ol = (float*)lds;
#pragma unroll
    for (int r = 0; r < 16; ++r) { const int orow = wid * QBLK + crow(r, hi);
#pragma unroll
        for (int d0 = 0; d0 < 4; ++d0) Ol[orow * 132 + d0 * 32 + r32] = o[d0][r] * rli[r]; }
    __syncthreads();
#pragma unroll
    for (int i = 0; i < 8; ++i) { const int idx = tid + 512 * i, row = idx >> 4, c8 = (idx & 15) * 8;
        const f32x4 a = *(const f32x4*)(Ol + row * 132 + c8), b = *(const f32x4*)(Ol + row * 132 + c8 + 4);
        const u32x4 z = zr[i];
        u32x4 w; w.x = cvt_pk(a[0] * bflo(z.x), a[1] * bfhi(z.x)); w.y = cvt_pk(a[2] * bflo(z.y), a[3] * bfhi(z.y));
        w.z = cvt_pk(b[0] * bflo(z.z), b[1] * bfhi(z.z)); w.w = cvt_pk(b[2] * bflo(z.w), b[3] * bfhi(z.w));
        *(u32x4*)(Ob + (long)row * 1024 + c8) = w; }
    __syncthreads();
#undef LD8
#undef SLOAD
#undef SWRITE
#undef SWAIT
#undef RESC
}
}

__device__ void phase_attn(const Params& p, unsigned char* smem) {
    const bf16_t* P1 = (const bf16_t*)p.ws; bf16_t* OG = (bf16_t*)p.out + (size_t)MTOK * 1024;
    const int x = blockIdx.x & 7, wl = blockIdx.x >> 3;
    float gqm = 0.f, gkm = 0.f;
    for (int i = 0; i < 128; ++i) { gqm = fmaxf(gqm, fabsf(p.qng[i])); gkm = fmaxf(gkm, fabsf(p.kng[i])); }
    const float bound2 = (11.313708498984761f * 1.02f * gqm * gkm) * 1.4426950408889634f;
    const float negBC = bound2 > 64.f ? 64.f - bound2 : 0.f;
    for (int slot_ = 0; slot_ < (REP_PH == 5 ? 16 : 8); ++slot_) { const int slot = slot_ & 7;
        int pair, u, T, rb, hq, qb;
        if (slot < 4) { pair = x + 8 * (slot >> 1); u = wl + 32 * (slot & 1); T = 4096; rb = (pair >> 1) * 4096; hq = u >> 4; qb = u & 15; }
        else { pair = x + 8 * (slot - 4); u = wl; T = 2048; rb = NPROMPT + (pair >> 1) * 2048; hq = u >> 3; qb = u & 7; }
        const int kvh = pair & 1, hg = kvh * 4 + hq; const size_t q0 = (size_t)rb + qb * 256;
        att::attn_body(P1 + q0 * LDP + hg * 128, P1 + (size_t)rb * LDP + 1024 + kvh * 128, P1 + (size_t)rb * LDP + 1280 + kvh * 128,
                       P1 + q0 * LDP + 1536 + hg * 128, OG + q0 * 1024 + hg * 128, T, (char*)smem, qb * 256, p.qng, (const float*)(p.ws + OFF_ROPE), negBC);
    }
}


__device__ void panel_gates(const bf16_t* XB, const bf16_t* Wg  , float* gates, int r0) {
    int tid = threadIdx.x; asm volatile("" : "+v"(tid));
    const int wid = tid >> 6, lane = tid & 63, li = lane & 15, kq = lane >> 4;
    const bf16_t* xa = XB + (size_t)(r0 + (2 * wid) * 16 + li) * 1024 + kq * 8;
    const bf16_t* xb = xa + 16 * 1024;
    const bf16_t* wp = Wg + (size_t)li * 1024 + kq * 8;
    f32x4 acc0 = {0.f, 0.f, 0.f, 0.f}, acc1 = {0.f, 0.f, 0.f, 0.f};
    for (int kc = 0; kc < 4; ++kc) {
        bf16x8 wf[8], x0[8], x1[8];
#pragma unroll
        for (int u = 0; u < 8; ++u) { const int ko = (kc * 8 + u) * 32; wf[u] = *(const bf16x8*)(wp + ko); x0[u] = *(const bf16x8*)(xa + ko); x1[u] = *(const bf16x8*)(xb + ko); }
#pragma unroll
        for (int u = 0; u < 8; ++u) { acc0 = __builtin_amdgcn_mfma_f32_16x16x32_bf16(wf[u], x0[u], acc0, 0, 0, 0); acc1 = __builtin_amdgcn_mfma_f32_16x16x32_bf16(wf[u], x1[u], acc1, 0, 0, 0); }
    }
    *(f32x4*)(gates + (size_t)(r0 + (2 * wid) * 16 + li) * 16 + kq * 4) = acc0;
    *(f32x4*)(gates + (size_t)(r0 + (2 * wid + 1) * 16 + li) * 16 + kq * 4) = acc1;
}

#define XB_TMO      128
#define XB_XCNT(j)  (256  + 64 * (j))
#define XB_XSUB(j)  (1280 + 64 * (j))
#define XB_XGEN(j)  (2304 + 64 * (j))
#define XB_TOP      3328
#define XB_TOPGEN   3392
#define XCD_BAR_WORDS 3456
#define XB_SPIN_CAP (1u << 18)
__device__ __forceinline__ unsigned xb_ld(unsigned* p)              { return __hip_atomic_load(p, __ATOMIC_RELAXED, __HIP_MEMORY_SCOPE_AGENT); }
__device__ __forceinline__ unsigned xb_add(unsigned* p, unsigned v) { return __hip_atomic_fetch_add(p, v, __ATOMIC_RELAXED, __HIP_MEMORY_SCOPE_AGENT); }
__device__ __forceinline__ unsigned xb_xcc_id() { return (unsigned)__builtin_amdgcn_s_getreg((3 << 11) | 20) & 0xFu; }
#define XB_SPIN(cond, bar) do { unsigned _sp = 0; while (cond) { __builtin_amdgcn_s_sleep(1); \
    if ((++_sp & 255u) == 0u) { if (xb_ld(&(bar)[XB_TMO])) break; if (_sp > XB_SPIN_CAP) { atomicAdd(&(bar)[XB_TMO], 1u); break; } } } } while (0)
struct XcdBarrier { unsigned* bar; unsigned x; volatile LAS unsigned* st; };
__device__ __forceinline__ XcdBarrier xcd_barrier_post(unsigned* bar, volatile LAS unsigned* st) {
    XcdBarrier b; b.bar = bar; b.x = xb_xcc_id(); b.st = st;
    if (threadIdx.x == 0) (void)xb_add(&bar[XB_XCNT(b.x)], 1u);
    return b;
}
__device__ __forceinline__ void xcd_barrier_complete(unsigned* bar, unsigned x, unsigned& nloc, unsigned& nx) {
    const unsigned G = gridDim.x * gridDim.y * gridDim.z;
    unsigned sum, cnt, mine, sp = 0u;
    for (;;) {
        sum = 0u; cnt = 0u; mine = 0u;
#pragma unroll
        for (unsigned j = 0; j < 16; ++j) { const unsigned c = xb_ld(&bar[XB_XCNT(j)]); sum += c; cnt += (c > 0u) ? 1u : 0u; mine = (j == x) ? c : mine; }
        if (sum == G) break;
        __builtin_amdgcn_s_sleep(1);
        if ((++sp & 255u) == 0u) { if (xb_ld(&bar[XB_TMO])) break; if (sp > XB_SPIN_CAP) { atomicAdd(&bar[XB_TMO], 1u); break; } }
    }
    nloc = mine > 0u ? mine : 1u; nx = cnt > 0u ? cnt : 1u;
}
__device__ __forceinline__ void xcd_barrier(const XcdBarrier& b) {
    asm volatile("s_waitcnt vmcnt(0)" ::: "memory");
    __syncthreads();
    if (threadIdx.x == 0) {
        unsigned* bar = b.bar;
        __builtin_amdgcn_s_waitcnt(0);
        unsigned nloc = b.st[0], nx = b.st[1];
        if (nloc == 0u) { xcd_barrier_complete(bar, b.x, nloc, nx); b.st[0] = nloc; b.st[1] = nx; }
        const unsigned old = xb_add(&bar[XB_XSUB(b.x)], 1u);
        const unsigned gen = old / nloc;
        if (old + 1u == (gen + 1u) * nloc) {
            __builtin_amdgcn_fence(__ATOMIC_RELEASE, "agent");
            asm volatile("s_waitcnt vmcnt(0)" ::: "memory");
            const unsigned og = xb_add(&bar[XB_TOP], 1u);
            const unsigned tg = og / nx;
            if (og + 1u == (tg + 1u) * nx) xb_add(&bar[XB_TOPGEN], 1u);
            else XB_SPIN(xb_ld(&bar[XB_TOPGEN]) == tg, bar);
            __builtin_amdgcn_fence(__ATOMIC_ACQUIRE, "agent");
            xb_add(&bar[XB_XGEN(b.x)], 1u);
            asm volatile("s_waitcnt vmcnt(0)" ::: "memory");
        } else {
            XB_SPIN(xb_ld(&bar[XB_XGEN(b.x)]) == gen, bar);
            __builtin_amdgcn_fence(__ATOMIC_ACQUIRE, "agent");
            asm volatile("s_waitcnt vmcnt(0)" ::: "memory");
        }
    }
    __syncthreads();
}

__global__ __launch_bounds__(512, 2) void mk_fwd(Params p) {
    extern __shared__ __attribute__((aligned(16))) unsigned char smem[];
    cg::grid_group grid = cg::this_grid();
    LAS unsigned char* lds = (LAS unsigned char*)smem;
    bf16_t* P0 = (bf16_t*)p.ws; float* Y = (float*)p.ws;
    bf16_t* XB = (bf16_t*)p.out; bf16_t* CAT0 = XB + (size_t)MTOK * 1024;
#ifndef ONLY_PH
#define ONLY_PH -1
#endif
#define RUN(n) (p.ph_lo <= (n) && (n) < p.ph_hi && (ONLY_PH < 0 || ONLY_PH == (n)))
#define REPEAT(n) for (int rep_ = 0; rep_ < ((REP_PH == (n)) ? 2 : 1); ++rep_)
#define SYNC(n) do { if (p.ph_lo <= (n) && (n) + 1 < p.ph_hi) { if ((n) == 0 || MK_MULTI) { grid.sync(); if ((n) == 0) xb = xcd_barrier_post((unsigned*)(p.ws + OFF_BAR), xst); } else xcd_barrier(xb); } } while (0)
    volatile LAS unsigned* xst = (volatile LAS unsigned*)(lds + (LDS_BYTES - 16));
    if (threadIdx.x == 0) { xst[0] = 0u; xst[1] = 0u; }
    __syncthreads();
    XcdBarrier xb; xb.bar = (unsigned*)(p.ws + OFF_BAR); xb.x = 0u; xb.st = xst;
    if (RUN(0)) phase_prep(p, smem);
    if (REP_PH == 0) { grid.sync(); phase_prep(p, smem); }
    SYNC(0);
    if (REP_PH == 13) { grid.sync(); grid.sync(); grid.sync(); grid.sync(); }
    if (RUN(1)) {
        pg8::PanelOrder S{(int)blockIdx.x, 12};
        pg8::EpiP0 E{P0, (float*)(p.ws + OFF_GATES)};
        pg8::gemm_phase(lds, pg8::Gemm{XB, (const bf16_t*)(p.ws + OFF_WT0), MTOK, 3072, 1024, 1024}, S, E);
        panel_gates(XB, (const bf16_t*)(p.ws + OFF_WT0) + (size_t)3072 * 1024, (float*)(p.ws + OFF_GATES), (int)blockIdx.x * 256);
    }
    SYNC(1);
    if (RUN(2)) phase_mix(p, smem);
    SYNC(2);
    if (RUN(3)) phase_scan(p, smem);
    SYNC(3);
    if (RUN(4)) {
        const int pm = blockIdx.x, r0 = pm * 256;
        panel_outb(p, r0);
        __builtin_amdgcn_fence(__ATOMIC_SEQ_CST, "workgroup"); __syncthreads();
        { pg8::PanelOrder S{pm, 4}; pg8::EpiRes<0> E{P0, nullptr};
          pg8::gemm_phase(lds, pg8::Gemm{CAT0, (const bf16_t*)(p.ws + OFF_WO0T), MTOK, 1024, 1024, 1024}, S, E); }
        __builtin_amdgcn_fence(__ATOMIC_SEQ_CST, "workgroup"); __syncthreads();
        panel_ln<0>(P0, p.xp, p.xs, p.ln_g, p.ln_b, XB, r0);
        __builtin_amdgcn_fence(__ATOMIC_SEQ_CST, "workgroup"); __syncthreads();
        { pg8::PanelOrder S{pm, 10}; pg8::EpiBf E{P0};
          pg8::gemm_phase(lds, pg8::Gemm{XB, (const bf16_t*)(p.ws + OFF_WT1), MTOK, 2560, 1024, 1024}, S, E); }
        __builtin_amdgcn_fence(__ATOMIC_SEQ_CST, "workgroup"); __syncthreads();
        panel_qknorm(p, r0);
    }
    SYNC(4);
    if (RUN(5)) phase_attn(p, smem);
    SYNC(5);
    if (RUN(6)) {
        pg8::PanelOrder S{(int)blockIdx.x, 4}; pg8::EpiRes<1> E{P0, XB};
        pg8::gemm_phase(lds, pg8::Gemm{CAT0, (const bf16_t*)(p.ws + OFF_WO1T), MTOK, 1024, 1024, 1024}, S, E);
    }
    SYNC(6);
    if (RUN(7)) panel_ln<1>(P0, nullptr, nullptr, p.ln_g + 1024, p.ln_b + 1024, p.out, (int)blockIdx.x * 256);
}

extern "C" void kernel_launch(void* const* d_in, const int* in_sizes, int n_in, void* d_out, int out_size, void* d_ws, size_t ws_size, hipStream_t stream) {
    static int ok = 0;
    if (ok == 0) {
        if (n_in != 20 || out_size != MTOK * DM || ws_size < WS_END) { fprintf(stderr, "kernel_launch: unexpected shapes n_in %d out %d ws %zu (need %zu)\n", n_in, out_size, ws_size, (size_t)WS_END); ok = -1; return; }
        if (hipFuncSetAttribute((const void*)mk_fwd, hipFuncAttributeMaxDynamicSharedMemorySize, LDS_BYTES) != hipSuccess) { fprintf(stderr, "kernel_launch: hipFuncSetAttribute failed\n"); ok = -1; return; }
        int dev = 0, cus = 0, per_cu = 0;
        hipGetDevice(&dev); hipDeviceGetAttribute(&cus, hipDeviceAttributeMultiprocessorCount, dev);
        hipOccupancyMaxActiveBlocksPerMultiprocessor(&per_cu, (const void*)mk_fwd, 512, LDS_BYTES);
        if (cus * per_cu < 256) { fprintf(stderr, "kernel_launch: %d CUs x %d blocks cannot hold the 256-workgroup grid\n", cus, per_cu); ok = -1; return; }
        ok = 1;
    }
    if (ok < 0) return;
    Params p{};
    p.xp = (const float*)d_in[0]; p.xs = (const float*)d_in[1]; p.w_in_even = (const float*)d_in[2]; p.w_pool = (const float*)d_in[3]; p.pool_scale = (const float*)d_in[4];
    p.conv_w = (const float*)d_in[5]; p.conv_b = (const float*)d_in[6]; p.w_q = (const float*)d_in[7]; p.w_k = (const float*)d_in[8]; p.bgi = (const float*)d_in[9];
    p.bgf = (const float*)d_in[10]; p.mh_g = (const float*)d_in[11]; p.skip = (const float*)d_in[12]; p.w_out_even = (const float*)d_in[13]; p.w_in_odd = (const float*)d_in[14];
    p.qng = (const float*)d_in[15]; p.kng = (const float*)d_in[16]; p.w_out_odd = (const float*)d_in[17]; p.ln_g = (const float*)d_in[18]; p.ln_b = (const float*)d_in[19];
    p.out = (float*)d_out; p.ws = (unsigned char*)d_ws;
#if MK_MULTI
    for (int ph = 0; ph < 8; ++ph) { p.ph_lo = ph; p.ph_hi = ph + 1; void* args[] = {&p};
        hipError_t e = hipLaunchCooperativeKernel((const void*)mk_fwd, dim3(256), dim3(512), args, LDS_BYTES, stream);
        if (e != hipSuccess) { fprintf(stderr, "kernel_launch: launch %d failed: %s\n", ph, hipGetErrorString(e)); return; } }
#else
    p.ph_lo = 0; p.ph_hi = 8; void* args[] = {&p};
    hipError_t e = hipLaunchCooperativeKernel((const void*)mk_fwd, dim3(256), dim3(512), args, LDS_BYTES, stream);
    if (e != hipSuccess) fprintf(stderr, "kernel_launch: cooperative launch failed: %s\n", hipGetErrorString(e));
#endif
}
```

```cpp
#include <hip/hip_runtime.h>
#include <hip/hip_cooperative_groups.h>
#include <cstdio>
namespace cg = cooperative_groups;

#ifndef MK_MULTI
#define MK_MULTI 0
#endif

#ifndef REP_PH
#define REP_PH -1
#endif
typedef unsigned short bf16_t;
typedef short bf16x8 __attribute__((ext_vector_type(8)));
typedef short s16x4 __attribute__((ext_vector_type(4)));
typedef float f32x4 __attribute__((ext_vector_type(4)));
typedef float f32x16 __attribute__((ext_vector_type(16)));
typedef unsigned u32x4 __attribute__((ext_vector_type(4)));
typedef unsigned u32x2 __attribute__((ext_vector_type(2)));
#define LAS __attribute__((address_space(3)))

constexpr int MTOK = 65536, NPROMPT = 32768, DM = 1024;
constexpr int LDP = 3072;
constexpr size_t P0_BYTES = (size_t)MTOK * LDP * 2;
constexpr size_t OFF_WT0 = P0_BYTES;
constexpr size_t OFF_WO0T = OFF_WT0 + (size_t)3328 * 1024 * 2;
constexpr size_t OFF_WT1 = OFF_WO0T + (size_t)1024 * 1024 * 2;
constexpr size_t OFF_WO1T = OFF_WT1 + (size_t)2560 * 1024 * 2;
constexpr size_t OFF_WPT = OFF_WO1T + (size_t)1024 * 1024 * 2;
constexpr size_t OFF_WQT = OFF_WPT + 131072;
constexpr size_t OFF_WKT = OFF_WQT + 131072;
constexpr size_t OFF_GATES = OFF_WKT + 131072;
constexpr size_t OFF_BAR = OFF_GATES + (size_t)MTOK * 16 * 4;
constexpr size_t OFF_SCR = OFF_BAR + 3456 * 4;
constexpr int SCR_ITEM = 32 * 384 + 64;
constexpr size_t OFF_ROPE = OFF_SCR + (size_t)192 * SCR_ITEM * 4;
constexpr size_t WS_END = OFF_ROPE + 64 * 32 * 2 * 4;
constexpr int LDS_BYTES = 136 * 1024;
constexpr float ALPHA = 1.41421356237309515f;

struct Params {
    const float* xp; const float* xs; const float* w_in_even; const float* w_pool; const float* pool_scale; const float* conv_w; const float* conv_b;
    const float* w_q; const float* w_k; const float* bgi; const float* bgf; const float* mh_g; const float* skip; const float* w_out_even;
    const float* w_in_odd; const float* qng; const float* kng; const float* w_out_odd; const float* ln_g; const float* ln_b;
    float* out; unsigned char* ws; int ph_lo, ph_hi;
};

__device__ __forceinline__ unsigned cvt_pk(float lo, float hi) { unsigned r; asm volatile("v_cvt_pk_bf16_f32 %0, %1, %2" : "=v"(r) : "v"(lo), "v"(hi)); return r; }
__device__ __forceinline__ float bflo(unsigned w) { return __uint_as_float(w << 16); }
__device__ __forceinline__ float bfhi(unsigned w) { return __uint_as_float(w & 0xffff0000u); }
__device__ __forceinline__ bf16_t f2bf(float f) { unsigned u = __float_as_uint(f); u += 0x7FFFu + ((u >> 16) & 1u); return (bf16_t)(u >> 16); }
__device__ __forceinline__ float sigm(float x) { return __builtin_amdgcn_rcpf(1.f + __expf(-x)); }
__device__ __forceinline__ float silu(float x) { return x * sigm(x); }
__device__ __forceinline__ int swz(int row, int chunk) { return row * 256 + ((chunk ^ (row & 15)) << 4); }

namespace pg8 {
constexpr int BM = 256, BK = 64, HALF = 128, HTB = HALF * BK * 2, STAGE_BYTES = 8 * HTB;
__device__ __forceinline__ int lds_byte(int r, int c) { const int st = (r >> 4) * 2 + (c >> 5), rr = r & 15, cc = c & 31, ob = rr * 64 + cc * 2; return st * 1024 + (ob ^ (((ob >> 9) & 1) << 5)); }
__device__ __forceinline__ void stage_rc(int b, int& R, int& C) { const int st = b / 1024, sb = b % 1024, sw = sb ^ (((sb >> 9) & 1) << 5); R = (st >> 1) * 16 + sw / 64; C = (st & 1) * 32 + (sw % 64) / 2; }
__device__ __forceinline__ int perm32(int rho) { const int n = rho >> 4, i = rho & 15; return 8 * (i >> 2) + 4 * n + (i & 3); }
struct Unit { int pm, pn; };
struct Gemm { const bf16_t* A; const bf16_t* Bt; int M, N, K, lda; };
struct StaticOrder {
    int nM, nN, nwg, G, c;
    __device__ void init(int M, int N, int G_, int c_) { nM = M / BM; nN = N / BM; nwg = nM * nN; G = G_; c = c_; }
    __device__ bool next(int i, Unit& u) const {
        if (REP_PH == 1 && i >= 13 && i < 26) i -= 13;
        const long L = (long)i * G + c; if (L >= nwg) return false;
        int wgid = (int)L; { const int q = nwg / 8, r = nwg % 8, xcd = wgid % 8, off = wgid / 8; wgid = (xcd < r ? xcd * (q + 1) : r * (q + 1) + (xcd - r) * q) + off; }
        const int nig = 8 * nN, gid = wgid / nig, fm = gid * 8, gsz = (nM - fm) < 8 ? (nM - fm) : 8;
        u.pm = fm + ((wgid % nig) % gsz); u.pn = (wgid % nig) / gsz; return true;
    }
};
struct PanelOrder {
    int pm, nN;
    __device__ bool next(int i, Unit& u) const { if (REP_PH == 12 && nN == 4) { if (i >= 8) return false; u.pm = pm; u.pn = i & 3; return true; }
        if (i >= nN) return false; u.pm = pm; u.pn = i; return true; }
};

template <class Epi, class Sched>
__device__ __forceinline__ void gemm_phase(LAS unsigned char* lds, const Gemm g, const Sched& S, const Epi& E) {
    int tid = threadIdx.x; asm volatile("" : "+v"(tid));
    const int wid = __builtin_amdgcn_readfirstlane(tid >> 6), lane = tid & 63, wr = wid >> 2, wc = wid & 3, fr = lane & 15, fq = lane >> 4;
    const int K = g.K, nt = K / BK, lda = g.lda;
    unsigned voffA[2], voffB[2];
#pragma unroll
    for (int i = 0; i < 2; ++i) { int R, C; stage_rc(tid * 16 + i * 8192, R, C); const int Rb = Epi::PERM ? ((R & ~31) + perm32(R & 31)) : R;
        voffA[i] = (unsigned)(R * lda + C) * 2u; voffB[i] = (unsigned)(Rb * K + C) * 2u; }
    const size_t kstep = (size_t)(BK * 2);
    const size_t hA = (size_t)HALF * lda * 2, hB = (size_t)HALF * K * 2;
    const size_t tA = 2 * hA, tB = 2 * hB;
    const unsigned ldsw = (unsigned)wid * 1024u;
    const int aoff = lds_byte(wr * 64 + fr, fq * 8), boff = lds_byte(wc * 32 + fr, fq * 8);
#define PG8_SA(b, h) (((b) * 2 + (h)) * HTB)
#define PG8_SB(b, h) ((4 + (b) * 2 + (h)) * HTB)
#define PG8_STAGE(bufoff, gbase, voff) do { const char* _gb = (const char*)(gbase); asm volatile("" : "+s"(_gb)); _Pragma("unroll") for (int _i = 0; _i < 2; ++_i) \
        __builtin_amdgcn_global_load_lds((const unsigned*)(_gb + (voff)[_i]), (LAS unsigned*)(lds + (bufoff) + ldsw + _i * 8192), 16, 0, 0); } while (0)
#define PG8_LDA(dst, b, h) do { _Pragma("unroll") for (int m = 0; m < 4; ++m) _Pragma("unroll") for (int k = 0; k < 2; ++k) dst[m][k] = *(const LAS bf16x8*)(lds + PG8_SA(b, h) + aoff + m * 2048 + k * 1024); } while (0)
#define PG8_LDB(dst, b, h) do { _Pragma("unroll") for (int n = 0; n < 2; ++n) _Pragma("unroll") for (int k = 0; k < 2; ++k) dst[n][k] = *(const LAS bf16x8*)(lds + PG8_SB(b, h) + boff + n * 2048 + k * 1024); } while (0)
#define PG8_MMA(ai, bj, At, Bt) do { __builtin_amdgcn_s_setprio(1); _Pragma("unroll") for (int m = 0; m < 4; ++m) _Pragma("unroll") for (int n = 0; n < 2; ++n) _Pragma("unroll") for (int k = 0; k < 2; ++k) \
        acc[ai][bj][m][n] = __builtin_amdgcn_mfma_f32_16x16x32_bf16(Bt[n][k], At[m][k], acc[ai][bj][m][n], 0, 0, 0); __builtin_amdgcn_s_setprio(0); } while (0)
#define PG8_WAIT_V(n) asm volatile("s_waitcnt vmcnt(" #n ")" ::: "memory")
#define PG8_WAIT_L(n) asm volatile("s_waitcnt lgkmcnt(" #n ")" ::: "memory")
#define PG8_BAR __builtin_amdgcn_s_barrier()
#define PG8_SCHED __builtin_amdgcn_sched_barrier(0)
    Unit cur, nxt; int ui = 0;
    if (!S.next(0, cur)) return;
    f32x4 acc[2][2][4][2];
#pragma unroll
    for (int a = 0; a < 2; ++a)
#pragma unroll
        for (int b = 0; b < 2; ++b)
#pragma unroll
            for (int m = 0; m < 4; ++m)
#pragma unroll
                for (int n = 0; n < 2; ++n) acc[a][b][m][n] = (f32x4){0.f, 0.f, 0.f, 0.f};
    bf16x8 At[4][2], B0[2][2], B1[2][2];
    const char* cA = (const char*)g.A + (size_t)cur.pm * tA; const char* cB = (const char*)g.Bt + (size_t)cur.pn * tB;
    PG8_STAGE(PG8_SB(0, 0), cB, voffB); PG8_STAGE(PG8_SA(0, 0), cA, voffA); PG8_STAGE(PG8_SB(0, 1), cB + hB, voffB); PG8_STAGE(PG8_SA(0, 1), cA + hA, voffA);
    if (wr == 1) PG8_BAR;
    PG8_WAIT_V(4); PG8_BAR;
    PG8_STAGE(PG8_SB(1, 0), cB + kstep, voffB); PG8_STAGE(PG8_SA(1, 0), cA + kstep, voffA); PG8_STAGE(PG8_SB(1, 1), cB + hB + kstep, voffB);
    PG8_WAIT_V(6); PG8_BAR;
    for (;;) {
        const bool has_next = S.next(ui + 1, nxt);
        const char* nA = has_next ? (const char*)g.A + (size_t)nxt.pm * tA : cA; const char* nB = has_next ? (const char*)g.Bt + (size_t)nxt.pn * tB : cB;
        for (int t = 0; t < nt; t += 2) {
            const bool last = (t == nt - 2);
            const char* a1 = cA + (size_t)(t + 1) * kstep;
            const char* a2 = last ? nA : cA + (size_t)(t + 2) * kstep; const char* b2 = last ? nB : cB + (size_t)(t + 2) * kstep;
            const char* a3 = a2 + kstep; const char* b3 = b2 + kstep;
            PG8_LDB(B0, 0, 0); PG8_SCHED; PG8_LDA(At, 0, 0); PG8_STAGE(PG8_SA(1, 1), a1 + hA, voffA);
            PG8_WAIT_L(8); PG8_BAR; PG8_WAIT_L(0); PG8_MMA(0, 0, At, B0); PG8_BAR; PG8_SCHED;
            PG8_LDB(B1, 0, 1); PG8_STAGE(PG8_SB(0, 0), b2, voffB);
            PG8_BAR; PG8_WAIT_L(0); PG8_MMA(0, 1, At, B1); PG8_BAR;
            PG8_LDA(At, 0, 1); PG8_STAGE(PG8_SA(0, 0), a2, voffA);
            PG8_BAR; PG8_WAIT_L(0); PG8_MMA(1, 0, At, B0); PG8_BAR; PG8_SCHED;
            PG8_STAGE(PG8_SB(0, 1), b2 + hB, voffB);
            PG8_WAIT_V(6); PG8_BAR; PG8_MMA(1, 1, At, B1); PG8_BAR;
            PG8_LDB(B0, 1, 0); PG8_SCHED; PG8_LDA(At, 1, 0); PG8_STAGE(PG8_SA(0, 1), a2 + hA, voffA);
            PG8_WAIT_L(8); PG8_BAR; PG8_WAIT_L(0); PG8_MMA(0, 0, At, B0); PG8_BAR; PG8_SCHED;
            PG8_LDB(B1, 1, 1); PG8_STAGE(PG8_SB(1, 0), b3, voffB);
            PG8_BAR; PG8_WAIT_L(0); PG8_MMA(0, 1, At, B1); PG8_BAR;
            PG8_LDA(At, 1, 1); PG8_STAGE(PG8_SA(1, 0), a3, voffA);
            PG8_BAR; PG8_WAIT_L(0); PG8_MMA(1, 0, At, B0); PG8_BAR; PG8_SCHED;
            PG8_STAGE(PG8_SB(1, 1), b3 + hB, voffB);
            PG8_WAIT_V(6); PG8_BAR; PG8_MMA(1, 1, At, B1); PG8_BAR;
        }
        E(acc, cur, wr, wc, fr, fq);
        if (!has_next) break;
#pragma unroll
        for (int a = 0; a < 2; ++a)
#pragma unroll
            for (int b = 0; b < 2; ++b)
#pragma unroll
                for (int m = 0; m < 4; ++m)
#pragma unroll
                    for (int n = 0; n < 2; ++n) acc[a][b][m][n] = (f32x4){0.f, 0.f, 0.f, 0.f};
        cur = nxt; cA = nA; cB = nB; ++ui;
    }
    PG8_WAIT_V(0);
    if (wr == 0) PG8_BAR;
    PG8_BAR;
#undef PG8_SA
#undef PG8_SB
#undef PG8_STAGE
#undef PG8_LDA
#undef PG8_LDB
#undef PG8_MMA
#undef PG8_WAIT_V
#undef PG8_WAIT_L
#undef PG8_BAR
#undef PG8_SCHED
}

struct EpiP0 {
    static constexpr bool PERM = true;
    bf16_t* P0; float* gates;
    __device__ __forceinline__ void operator()(const f32x4 (&acc)[2][2][4][2], const Unit& u, int wr, int wc, int fr, int fq) const {
        const int row0 = u.pm * BM + wr * 64 + fr;
        if (u.pn < 12) {
            const int col0 = u.pn * BM + wc * 32 + 8 * fq;
#pragma unroll
            for (int ai = 0; ai < 2; ++ai)
#pragma unroll
                for (int m = 0; m < 4; ++m) { bf16_t* rowp = P0 + (size_t)(row0 + ai * HALF + m * 16) * LDP + col0;
#pragma unroll
                    for (int bj = 0; bj < 2; ++bj) { const f32x4 v0 = acc[ai][bj][m][0], v1 = acc[ai][bj][m][1];
                        u32x4 w; w.x = cvt_pk(v0[0], v0[1]); w.y = cvt_pk(v0[2], v0[3]); w.z = cvt_pk(v1[0], v1[1]); w.w = cvt_pk(v1[2], v1[3]);
                        *(u32x4*)(rowp + bj * HALF) = w; } }
        } else if (wc == 0 && fq < 2) {
#pragma unroll
            for (int ai = 0; ai < 2; ++ai)
#pragma unroll
                for (int m = 0; m < 4; ++m) { float* gp = gates + (size_t)(row0 + ai * HALF + m * 16) * 16 + 8 * fq;
                    *(f32x4*)gp = acc[ai][0][m][0]; *(f32x4*)(gp + 4) = acc[ai][0][m][1]; }
        }
    }
};
struct EpiBf {
    static constexpr bool PERM = true;
    bf16_t* O;
    __device__ __forceinline__ void operator()(const f32x4 (&acc)[2][2][4][2], const Unit& u, int wr, int wc, int fr, int fq) const {
        const int row0 = u.pm * BM + wr * 64 + fr, col0 = u.pn * BM + wc * 32 + 8 * fq; const bool gate = u.pn >= 6;
#pragma unroll
        for (int ai = 0; ai < 2; ++ai)
#pragma unroll
            for (int m = 0; m < 4; ++m) { bf16_t* rowp = O + (size_t)(row0 + ai * HALF + m * 16) * LDP + col0;
#pragma unroll
                for (int bj = 0; bj < 2; ++bj) { f32x4 v0 = acc[ai][bj][m][0], v1 = acc[ai][bj][m][1];
                    if (gate) {
#pragma unroll
                        for (int e = 0; e < 4; ++e) { v0[e] = silu(v0[e]); v1[e] = silu(v1[e]); } }
                    u32x4 w; w.x = cvt_pk(v0[0], v0[1]); w.y = cvt_pk(v0[2], v0[3]); w.z = cvt_pk(v1[0], v1[1]); w.w = cvt_pk(v1[2], v1[3]);
                    *(u32x4*)(rowp + bj * HALF) = w; } }
    }
};
template <int RES_BF16> struct EpiRes {
    static constexpr bool PERM = true;
    bf16_t* Y; const bf16_t* xb;
    __device__ __forceinline__ void operator()(const f32x4 (&acc)[2][2][4][2], const Unit& u, int wr, int wc, int fr, int fq) const {
        const int row0 = u.pm * BM + wr * 64 + fr, col0 = u.pn * BM + wc * 32 + 8 * fq;
#pragma unroll
        for (int ai = 0; ai < 2; ++ai) {
            u32x4 res[4][2];
            if (RES_BF16) {
#pragma unroll
                for (int m = 0; m < 4; ++m)
#pragma unroll
                    for (int bj = 0; bj < 2; ++bj) res[m][bj] = *(const u32x4*)(xb + (size_t)(row0 + ai * HALF + m * 16) * 1024 + col0 + bj * HALF);
            }
#pragma unroll
            for (int m = 0; m < 4; ++m) { const int row = row0 + ai * HALF + m * 16; bf16_t* yp = Y + (size_t)row * LDP + col0;
#pragma unroll
                for (int bj = 0; bj < 2; ++bj) { f32x4 v0 = acc[ai][bj][m][0], v1 = acc[ai][bj][m][1];
                    if (RES_BF16) { const u32x4 w = res[m][bj];
                        v0 += (f32x4){bflo(w.x), bfhi(w.x), bflo(w.y), bfhi(w.y)} * ALPHA; v1 += (f32x4){bflo(w.z), bfhi(w.z), bflo(w.w), bfhi(w.w)} * ALPHA; }
                    u32x4 o; o.x = cvt_pk(v0[0], v0[1]); o.y = cvt_pk(v0[2], v0[3]); o.z = cvt_pk(v1[0], v1[1]); o.w = cvt_pk(v1[2], v1[3]);
                    *(u32x4*)(yp + bj * HALF) = o; } }
            __builtin_amdgcn_sched_barrier(0);
        }
    }
};
}

template <int NB> __device__ __forceinline__ void mm16(f32x4 (&acc)[NB], const unsigned char* Xs, const bf16x8 (&yf)[4], int lane) {
    const int i = lane & 15, kq = lane >> 4;
#pragma unroll
    for (int ks = 0; ks < 4; ++ks)
#pragma unroll
        for (int nb = 0; nb < NB; ++nb) {
            const bf16x8 x = *(const bf16x8*)(Xs + swz(nb * 16 + i, ks * 4 + kq));
            acc[nb] = __builtin_amdgcn_mfma_f32_16x16x32_bf16(x, yf[ks], acc[nb], 0, 0, 0);
            if ((nb & 3) == 3) __builtin_amdgcn_sched_barrier(0);
        }
}
__device__ __forceinline__ void ldfrag(bf16x8 (&f)[4], const unsigned char* Ts, int rb, int lane) {
#pragma unroll
    for (int ks = 0; ks < 4; ++ks) f[ks] = *(const bf16x8*)(Ts + swz(rb * 16 + (lane & 15), ks * 4 + (lane >> 4)));
}
__device__ __forceinline__ void stage_tile(unsigned char* dst, const bf16_t* src, int ld) {
    for (int idx = threadIdx.x; idx < 2048; idx += 512) { const int row = idx >> 4, ch = idx & 15;
        *(u32x4*)(dst + swz(row, ch)) = *(const u32x4*)(src + (size_t)row * ld + ch * 8); }
}

__device__ void phase_prep(const Params& p, unsigned char* smem) {
    const int tid = threadIdx.x;
    if (blockIdx.x == 0) for (int i = tid; i < 3456; i += 512) ((unsigned*)(p.ws + OFF_BAR))[i] = 0u;
    if (blockIdx.x == 1) for (int i = tid; i < 2048; i += 512) { const float inv = exp2f(-(float)(i & 31) * (13.287712379549449f / 32.f)); float sn, cs; __sincosf((float)(i >> 5) * inv, &sn, &cs);
        ((float2*)(p.ws + OFF_ROPE))[i] = make_float2(cs, sn); }
    bf16_t* XB = (bf16_t*)p.out;
    const size_t n8 = (size_t)MTOK * DM / 8, half8 = (size_t)NPROMPT * DM / 8;
    for (size_t i = (size_t)blockIdx.x * 512 + tid; i < n8; i += (size_t)gridDim.x * 512) {
        const float* src = i < half8 ? p.xp + i * 8 : p.xs + (i - half8) * 8;
        const f32x4 a = __builtin_nontemporal_load((const f32x4*)src), b = __builtin_nontemporal_load((const f32x4*)(src + 4));
        u32x4 w; w.x = cvt_pk(a[0], a[1]); w.y = cvt_pk(a[2], a[3]); w.z = cvt_pk(b[0], b[1]); w.w = cvt_pk(b[2], b[3]);
        *(u32x4*)(XB + i * 8) = w;
    }
    float* t = (float*)smem;
    for (int ti = blockIdx.x; ti < 2032; ti += gridDim.x) {
        const float* src; bf16_t* dst; int K, N, tn, li; float scale = 1.f;
        if (ti < 832) { src = p.w_in_even; dst = (bf16_t*)(p.ws + OFF_WT0); K = 1024; N = 3088; tn = 52; li = ti; }
        else if (ti < 1088) { src = p.w_out_even; dst = (bf16_t*)(p.ws + OFF_WO0T); K = 1024; N = 1024; tn = 16; li = ti - 832; }
        else if (ti < 1728) { src = p.w_in_odd; dst = (bf16_t*)(p.ws + OFF_WT1); K = 1024; N = 2560; tn = 40; li = ti - 1088; }
        else if (ti < 1984) { src = p.w_out_odd; dst = (bf16_t*)(p.ws + OFF_WO1T); K = 1024; N = 1024; tn = 16; li = ti - 1728; }
        else { const int si = ti - 1984, which = si >> 4, mat = (si >> 2) & 3; li = si & 3; K = 128; N = 128; tn = 2;
            if (which == 0) { src = p.w_pool + mat * 16384; dst = (bf16_t*)(p.ws + OFF_WPT) + mat * 16384; }
            else if (which == 1) { src = p.w_q + mat * 16384; dst = (bf16_t*)(p.ws + OFF_WQT) + mat * 16384; }
            else { src = p.w_k + mat * 16384; dst = (bf16_t*)(p.ws + OFF_WKT) + mat * 16384; scale = 0.08838834764831845f; } }
        const int k0 = (li / tn) * 64, n0 = (li % tn) * 64;
#pragma unroll
        for (int e = 0; e < 8; ++e) { const int idx = e * 512 + tid, kk = idx >> 6, nn = idx & 63, n = n0 + nn;
            t[kk * 65 + nn] = (n < N) ? src[(size_t)(k0 + kk) * N + n] * scale : 0.f; }
        __syncthreads();
#pragma unroll
        for (int e = 0; e < 8; ++e) { const int idx = e * 512 + tid, nn = idx >> 6, kk = idx & 63;
            dst[(size_t)(n0 + nn) * K + k0 + kk] = f2bf(t[kk * 65 + nn]); }
        __syncthreads();
    }
}

__device__ void phase_mix(const Params& p, unsigned char* smem) {
    int tid = threadIdx.x; asm volatile("" : "+v"(tid));
    const int wid = tid >> 6, lane = tid & 63, li = lane & 15, kq = lane >> 4;
    const bf16_t* P0 = (const bf16_t*)p.ws;
    bf16_t* CAT0 = (bf16_t*)p.out + (size_t)MTOK * 1024;
    bf16_t* Q0 = (bf16_t*)p.out; bf16_t* K0 = Q0 + (size_t)MTOK * 512;
    unsigned char* As = smem; unsigned char* Bs = smem + 32768; unsigned char* B2s = smem + 65536; unsigned char* halo = smem + 65536;
    const int g = blockIdx.x & 3;
    stage_tile(Bs, (const bf16_t*)(p.ws + OFF_WPT) + g * 16384, 128);
    const int tstep = gridDim.x >> 2, tlim = (REP_PH == 2 ? 1024 : 512);
#define TILE_DECODE(tile_) const int tile = (tile_) & 511; const int r0 = tile * 128; int T, ts0; \
        if (r0 < NPROMPT) { T = 4096; ts0 = r0 & 4095; } else { T = 2048; ts0 = (r0 - NPROMPT) & 2047; }
    {
        const int left = 1 << g, right = (1 << g) - 1;
        u32x4 hreg[5];
#define HLOAD(tile_) do { TILE_DECODE(tile_); const int seqbase = r0 - ts0; \
        _Pragma("unroll") for (int i = 0; i < 5; ++i) { const int idx = tid + 512 * i, row = idx >> 4, ch = idx & 15, tt = ts0 - 8 + row; \
            hreg[i] = (u32x4){0u, 0u, 0u, 0u}; \
            if (idx < 2304 && tt >= 0 && tt < T) hreg[i] = *(const u32x4*)(P0 + (size_t)(seqbase + tt) * LDP + g * 128 + ch * 8); } } while (0)
        HLOAD(blockIdx.x >> 2);
        for (int tile_ = blockIdx.x >> 2; tile_ < tlim; tile_ += tstep) {
            TILE_DECODE(tile_);
#pragma unroll
            for (int i = 0; i < 5; ++i) { const int idx = tid + 512 * i; if (idx < 2304) *(u32x4*)(halo + (idx >> 4) * 256 + (idx & 15) * 16) = hreg[i]; }
            const size_t r = (size_t)r0 + wid * 16 + li;
            u32x2 zreg[8];
#pragma unroll
            for (int nb = 0; nb < 8; ++nb) zreg[nb] = *(const u32x2*)(P0 + r * LDP + 512 + g * 128 + nb * 16 + kq * 4);
            __syncthreads();
            { const int c2 = tid & 63, tq = tid >> 6;
              float s0 = 0.f, s1 = 0.f; const int tl0 = tq * 16;
              for (int j = tl0 - left; j <= tl0 + right; ++j) { const unsigned w = *(const unsigned*)(halo + (j + 8) * 256 + c2 * 4); s0 += bflo(w); s1 += bfhi(w); }
              for (int tl = tl0; tl < tl0 + 16; ++tl) { const int t = ts0 + tl; const int lo = max(t - left, 0), hi = min(t + right + 1, T);
                  const float inv = __builtin_amdgcn_rcpf((float)(hi - lo)); const unsigned xw = *(const unsigned*)(halo + (tl + 8) * 256 + c2 * 4);
                  *(unsigned*)(As + swz(tl, c2 >> 2) + (c2 & 3) * 4) = cvt_pk(s0 * inv - bflo(xw), s1 * inv - bfhi(xw));
                  const unsigned wn = *(const unsigned*)(halo + (tl + 1 + right + 8) * 256 + c2 * 4), wo = *(const unsigned*)(halo + (tl - left + 8) * 256 + c2 * 4);
                  s0 += bflo(wn) - bflo(wo); s1 += bfhi(wn) - bfhi(wo); } }
            __syncthreads();
            HLOAD((tile_ + tstep < tlim) ? tile_ + tstep : tile_);
            bf16x8 af[4]; ldfrag(af, As, wid, lane);
            f32x4 acc[8];
#pragma unroll
            for (int nb = 0; nb < 8; ++nb) acc[nb] = (f32x4){0.f, 0.f, 0.f, 0.f};
            mm16<8>(acc, Bs, af, lane);
#pragma unroll
            for (int nb = 0; nb < 8; ++nb) { const int d = nb * 16 + kq * 4;
                const u32x2 za = zreg[nb]; const f32x4 ps = *(const f32x4*)(p.pool_scale + g * 128 + d);
                u32x2 o; o.x = cvt_pk(acc[nb][0] * ps[0] * silu(bflo(za.x)), acc[nb][1] * ps[1] * silu(bfhi(za.x)));
                o.y = cvt_pk(acc[nb][2] * ps[2] * silu(bflo(za.y)), acc[nb][3] * ps[3] * silu(bfhi(za.y)));
                *(u32x2*)(CAT0 + r * 1024 + g * 128 + d) = o; }
        }
#undef HLOAD
    }
    __syncthreads();
    {
        const int h = g;
        stage_tile(Bs, (const bf16_t*)(p.ws + OFF_WQT) + h * 16384, 128);
        stage_tile(B2s, (const bf16_t*)(p.ws + OFF_WKT) + h * 16384, 128);
        const int ch = tid & 15, cc = h * 128 + ch * 8;
        float cw[3][8], cb[8];
#pragma unroll
        for (int e = 0; e < 8; ++e) { cb[e] = p.conv_b[cc + e];
#pragma unroll
            for (int j = 0; j < 3; ++j) cw[j][e] = p.conv_w[j * 512 + cc + e]; }
        u32x4 creg[4][3];
#define CLOAD(tile_) do { TILE_DECODE(tile_); \
        _Pragma("unroll") for (int i = 0; i < 4; ++i) { const int tl = (tid >> 4) + 32 * i, t = ts0 + tl; const long r = (long)r0 + tl; \
            _Pragma("unroll") for (int j = 0; j < 3; ++j) { const int tt = t - 1 + j; creg[i][j] = (u32x4){0u, 0u, 0u, 0u}; \
                if (tt >= 0 && tt < T) creg[i][j] = *(const u32x4*)(P0 + (size_t)(r - 1 + j) * LDP + 1024 + cc); } } } while (0)
        CLOAD(blockIdx.x >> 2);
        for (int tile_ = blockIdx.x >> 2; tile_ < tlim; tile_ += tstep) {
            TILE_DECODE(tile_); (void)T; (void)ts0;
#pragma unroll
            for (int i = 0; i < 4; ++i) { const int tl = (tid >> 4) + 32 * i; const size_t r = (size_t)r0 + tl;
                float a[8];
#pragma unroll
                for (int e = 0; e < 8; ++e) a[e] = cb[e];
#pragma unroll
                for (int j = 0; j < 3; ++j) { const u32x4 v = creg[i][j];
                    a[0] += bflo(v.x) * cw[j][0]; a[1] += bfhi(v.x) * cw[j][1]; a[2] += bflo(v.y) * cw[j][2]; a[3] += bfhi(v.y) * cw[j][3];
                    a[4] += bflo(v.z) * cw[j][4]; a[5] += bfhi(v.z) * cw[j][5]; a[6] += bflo(v.w) * cw[j][6]; a[7] += bfhi(v.w) * cw[j][7]; }
                u32x4 w; w.x = cvt_pk(silu(a[0]), silu(a[1])); w.y = cvt_pk(silu(a[2]), silu(a[3])); w.z = cvt_pk(silu(a[4]), silu(a[5])); w.w = cvt_pk(silu(a[6]), silu(a[7]));
                *(u32x4*)(As + swz(tl, ch)) = w; *(u32x4*)(CAT0 + r * 1024 + 512 + cc) = w; }
            __syncthreads();
            CLOAD((tile_ + tstep < tlim) ? tile_ + tstep : tile_);
            bf16x8 af[4]; ldfrag(af, As, wid, lane);
            const size_t r = (size_t)r0 + wid * 16 + li;
#pragma unroll
            for (int which = 0; which < 2; ++which) {
                f32x4 acc[8];
#pragma unroll
                for (int nb = 0; nb < 8; ++nb) acc[nb] = (f32x4){0.f, 0.f, 0.f, 0.f};
                mm16<8>(acc, which ? B2s : Bs, af, lane);
                bf16_t* O = which ? K0 : Q0;
#pragma unroll
                for (int nb = 0; nb < 8; ++nb) { u32x2 o; o.x = cvt_pk(acc[nb][0], acc[nb][1]); o.y = cvt_pk(acc[nb][2], acc[nb][3]);
                    *(u32x2*)(O + r * 512 + h * 128 + nb * 16 + kq * 4) = o; }
            }
            __syncthreads();
        }
#undef CLOAD
    }
#undef TILE_DECODE
}

template <int SPLIT> __device__ __forceinline__ void scan_item(const Params& p, unsigned char* smem, const int item, const int vh) {
    constexpr int NBV = SPLIT ? 4 : 8;
    int tid = threadIdx.x; asm volatile("" : "+v"(tid));
    const int wid = tid >> 6, lane = tid & 63, li = lane & 15, kq = lane >> 4;
    bf16_t* P0 = (bf16_t*)p.ws;
    const bf16_t* Q0 = (const bf16_t*)p.out; const bf16_t* K0 = Q0 + (size_t)MTOK * 512;
    const float* GATES = (const float*)(p.ws + OFF_GATES);
    unsigned char* KP = smem; unsigned char* VT = smem + 32768; unsigned char* KT = smem + 65536; unsigned char* CS = smem + 98304;
    float* g_s = (float*)(smem + 131072); float* a_s = g_s + 128; float* M_s = a_s + 128; float* n_s = M_s + 128; float* sc = n_s + 128;
    {
        int b, h, dir, T, rb;
        if (item < 64) { b = item >> 3; h = (item >> 1) & 3; dir = item & 1; T = 4096; rb = b * 4096; }
        else { const int it = item - 64; b = it >> 3; h = (it >> 1) & 3; dir = it & 1; T = 2048; rb = NPROMPT + b * 2048; }
        const int nc = T >> 7;
        const int rfirst = dir ? rb + T - 1 : rb, rstep = dir ? -1 : 1;
        const float bgi = p.bgi[dir * 4 + h], bgf = p.bgf[dir * 4 + h];
        for (int idx = tid; idx < 2048; idx += 512) *(u32x4*)(CS + idx * 16) = (u32x4){0u, 0u, 0u, 0u};
        if (tid < 128) n_s[tid] = 0.f;
        float m_run = -1e30f;
        f32x4 Cacc[NBV];
#pragma unroll
        for (int nb = 0; nb < NBV; ++nb) Cacc[nb] = (f32x4){0.f, 0.f, 0.f, 0.f};
        const int vblk = SPLIT ? 4 * vh + (wid & 3) : wid, kh = SPLIT ? (wid >> 2) : 0;
        const int sp = tid & 31, ch = tid >> 5;
        u32x4 kreg[4], vreg[4]; bf16x8 qf[4];
#define SCAN_LOAD(j) do { \
        _Pragma("unroll") for (int i = 0; i < 4; ++i) { const size_t r = (size_t)(rfirst + rstep * ((j) * 128 + sp * 4 + i)); \
            kreg[i] = *(const u32x4*)(K0 + r * 512 + h * 128 + ch * 8); vreg[i] = *(const u32x4*)(P0 + r * LDP + 1536 + h * 128 + ch * 8); } \
        } while (0)
#define Q_LOAD(j) do { const size_t r = (size_t)(rfirst + rstep * ((j) * 128 + wid * 16 + li)); \
          _Pragma("unroll") for (int ks = 0; ks < 4; ++ks) qf[ks] = *(const bf16x8*)(Q0 + r * 512 + h * 128 + ks * 32 + kq * 8); } while (0)
#define GATE_LOAD(j) do { pg = *(const float2*)(scr + (j) * 384 + 2 * lane); pa = *(const float2*)(scr + (j) * 384 + 128 + 2 * lane); \
        ppm = *(const float2*)(scr + (j) * 384 + 256 + 2 * lane); pG = scr[32 * 384 + (j)]; pPM = scr[32 * 384 + 32 + (j)]; } while (0)
        float* scr = (float*)(p.ws + OFF_SCR) + (size_t)item * SCR_ITEM;
        for (int j = wid; j < nc; j += 8) {
            const size_t ra = (size_t)(rfirst + rstep * (j * 128 + 2 * lane)), rc = (size_t)(rfirst + rstep * (j * 128 + 2 * lane + 1));
            const float ig0 = GATES[ra * 16 + dir * 4 + h] + bgi, ig1 = GATES[rc * 16 + dir * 4 + h] + bgi;
            const float x0 = GATES[ra * 16 + 8 + dir * 4 + h] + bgf, x1 = GATES[rc * 16 + 8 + dir * 4 + h] + bgf;
            const float lf0 = fminf(x0, 0.f) - log1pf(expf(-fabsf(x0))), lf1 = fminf(x1, 0.f) - log1pf(expf(-fabsf(x1)));
            float ps = lf0 + lf1;
#pragma unroll
            for (int off = 1; off < 64; off <<= 1) { const float v = __shfl_up(ps, off); if (lane >= off) ps += v; }
            float ex = __shfl_up(ps, 1); if (lane == 0) ex = 0.f;
            const float g0 = ex + lf0, g1 = g0 + lf1;
            const float a0 = ig0 - g0, a1 = ig1 - g1;
            float pm = fmaxf(a0, a1);
#pragma unroll
            for (int off = 1; off < 64; off <<= 1) { const float v = __shfl_up(pm, off); if (lane >= off) pm = fmaxf(pm, v); }
            float pe = __shfl_up(pm, 1); if (lane == 0) pe = -3.0e38f;
            const float pm0 = fmaxf(pe, a0), pm1 = fmaxf(pm0, a1);
            float* cj = scr + j * 384;
            *(float2*)(cj + 2 * lane) = make_float2(g0, g1); *(float2*)(cj + 128 + 2 * lane) = make_float2(a0, a1); *(float2*)(cj + 256 + 2 * lane) = make_float2(pm0, pm1);
            if (lane == 63) { scr[32 * 384 + j] = g1; scr[32 * 384 + 32 + j] = pm1; }
        }
        __builtin_amdgcn_fence(__ATOMIC_SEQ_CST, "workgroup"); __syncthreads();
        float2 pg = make_float2(0.f, 0.f), pa = pg, ppm = pg; float pG = 0.f, pPM = 0.f;
        SCAN_LOAD(0); Q_LOAD(0);
        if (wid == 0) GATE_LOAD(0);
        for (int j = 0; j < nc; ++j) {
            const int jn = (j + 1 < nc) ? j + 1 : j;
            if (wid == 0) {
                const float M127 = fmaxf(m_run, pPM);
                g_s[2 * lane] = pg.x; g_s[2 * lane + 1] = pg.y; a_s[2 * lane] = pa.x; a_s[2 * lane + 1] = pa.y;
                M_s[2 * lane] = fmaxf(m_run, ppm.x); M_s[2 * lane + 1] = fmaxf(m_run, ppm.y);
                if (lane == 0) { sc[0] = m_run; sc[1] = M127; }
                m_run = pG + M127;
                GATE_LOAD(jn);
            }
            __syncthreads();
            const float m_old = sc[0], M127 = sc[1];
            const float decay = __expf(m_old - M127);
            {
                const f32x4 a4 = *(const f32x4*)(a_s + sp * 4);
                float wsv[4];
#pragma unroll
                for (int i = 0; i < 4; ++i) wsv[i] = __expf(a4[i] - M127);
#pragma unroll
                for (int i = 0; i < 4; ++i) { const u32x4 k = kreg[i]; u32x4 w;
                    w.x = cvt_pk(bflo(k.x) * wsv[i], bfhi(k.x) * wsv[i]); w.y = cvt_pk(bflo(k.y) * wsv[i], bfhi(k.y) * wsv[i]);
                    w.z = cvt_pk(bflo(k.z) * wsv[i], bfhi(k.z) * wsv[i]); w.w = cvt_pk(bflo(k.w) * wsv[i], bfhi(k.w) * wsv[i]);
                    *(u32x4*)(KP + swz(sp * 4 + i, ch)) = w; }
#pragma unroll
                for (int e2 = 0; e2 < 4; ++e2) {
                    const unsigned k0 = kreg[0][e2], k1 = kreg[1][e2], k2 = kreg[2][e2], k3 = kreg[3][e2];
                    const unsigned v0 = vreg[0][e2], v1 = vreg[1][e2], v2 = vreg[2][e2], v3 = vreg[3][e2];
                    const int d0 = ch * 8 + 2 * e2, d1 = d0 + 1; const int co = (sp & 1) * 8;
                    u32x2 o;
                    o.x = cvt_pk(bflo(k0) * wsv[0], bflo(k1) * wsv[1]); o.y = cvt_pk(bflo(k2) * wsv[2], bflo(k3) * wsv[3]);
                    *(u32x2*)(KT + swz(d0, sp >> 1) + co) = o;
                    o.x = cvt_pk(bfhi(k0) * wsv[0], bfhi(k1) * wsv[1]); o.y = cvt_pk(bfhi(k2) * wsv[2], bfhi(k3) * wsv[3]);
                    *(u32x2*)(KT + swz(d1, sp >> 1) + co) = o;
                    o.x = (v0 & 0xffffu) | (v1 << 16); o.y = (v2 & 0xffffu) | (v3 << 16);
                    *(u32x2*)(VT + swz(d0, sp >> 1) + co) = o;
                    o.x = (v0 >> 16) | (v1 & 0xffff0000u); o.y = (v2 >> 16) | (v3 & 0xffff0000u);
                    *(u32x2*)(VT + swz(d1, sp >> 1) + co) = o;
                }
            }
            const size_t rowl = (size_t)(rfirst + rstep * (j * 128 + wid * 16 + li));
            __syncthreads();
            SCAN_LOAD(jn);
            __builtin_amdgcn_sched_barrier(0);
            const int l = wid * 16 + li;
            const float Ml = M_s[l], gl = g_s[l];
            f32x4 acc[8];
#pragma unroll
            for (int nb = 0; nb < 8; ++nb) acc[nb] = (f32x4){0.f, 0.f, 0.f, 0.f};
            mm16<8>(acc, KP, qf, lane);
            __builtin_amdgcn_sched_barrier(0);
            float rs = 0.f; u32x2 pp[8];
            const float rowf = __expf(fminf(sc[1] - Ml, 80.f));
#pragma unroll
            for (int nb = 0; nb < 8; ++nb) { float pv[4];
#pragma unroll
                for (int jj = 0; jj < 4; ++jj) { const int s = nb * 16 + kq * 4 + jj; pv[jj] = (s <= l) ? acc[nb][jj] * rowf : 0.f; rs += pv[jj]; }
                pp[nb].x = cvt_pk(pv[0], pv[1]); pp[nb].y = cvt_pk(pv[2], pv[3]); }
            __builtin_amdgcn_sched_barrier(0);
            float nq = 0.f;
#pragma unroll
            for (int ks = 0; ks < 4; ++ks) { const f32x4 n0 = *(const f32x4*)(n_s + ks * 32 + kq * 8), n1 = *(const f32x4*)(n_s + ks * 32 + kq * 8 + 4);
                const u32x4 qw = *(const u32x4*)&qf[ks];
                nq += bflo(qw.x) * n0[0] + bfhi(qw.x) * n0[1] + bflo(qw.y) * n0[2] + bfhi(qw.y) * n0[3] + bflo(qw.z) * n1[0] + bfhi(qw.z) * n1[1] + bflo(qw.w) * n1[2] + bfhi(qw.w) * n1[3]; }
            rs += __shfl_xor(rs, 16); rs += __shfl_xor(rs, 32); nq += __shfl_xor(nq, 16); nq += __shfl_xor(nq, 32);
            const float exl = __expf(m_old - Ml);
            const float den = rs + exl * nq;
            const float hinv = __builtin_amdgcn_rcpf(fmaxf(fabsf(den), __expf(-(gl + Ml))));
            __syncthreads();
#pragma unroll
            for (int nb = 0; nb < 8; ++nb) *(u32x2*)(KP + swz(l, nb * 2 + (kq >> 1)) + (kq & 1) * 8) = pp[nb];
            f32x4 acc2[NBV];
#pragma unroll
            for (int nb = 0; nb < NBV; ++nb) acc2[nb] = (f32x4){0.f, 0.f, 0.f, 0.f};
            __builtin_amdgcn_sched_barrier(0);
            mm16<NBV>(acc2, CS + vh * 16384, qf, lane);
            __builtin_amdgcn_sched_barrier(0);
            Q_LOAD(jn);
#pragma unroll
            for (int nb = 0; nb < NBV; ++nb) acc2[nb] *= exl;
            __builtin_amdgcn_sched_barrier(0);
            { bf16x8 pf[4]; ldfrag(pf, KP, wid, lane); mm16<NBV>(acc2, VT + vh * 16384, pf, lane); }
            __builtin_amdgcn_sched_barrier(0);
            { bf16_t* hp = P0 + rowl * LDP + dir * 512 + h * 128 + vh * 64 + kq * 4;
#pragma unroll
              for (int nb = 0; nb < NBV; ++nb) { u32x2 o; o.x = cvt_pk(acc2[nb][0] * hinv, acc2[nb][1] * hinv); o.y = cvt_pk(acc2[nb][2] * hinv, acc2[nb][3] * hinv);
                  *(u32x2*)(hp + nb * 16) = o; } }
            __builtin_amdgcn_sched_barrier(0);
            float nnew;
            { bf16x8 vf[4]; ldfrag(vf, VT, vblk, lane);
#pragma unroll
              for (int nb = 0; nb < NBV; ++nb) Cacc[nb] *= decay;
              mm16<NBV>(Cacc, KT + kh * 16384, vf, lane);
              float part = 0.f;
#pragma unroll
              for (int ks = 0; ks < 4; ++ks) { const u32x4 kw = *(const u32x4*)(KT + swz(wid * 16 + li, ks * 4 + kq));
                  part += bflo(kw.x) + bfhi(kw.x) + bflo(kw.y) + bfhi(kw.y) + bflo(kw.z) + bfhi(kw.z) + bflo(kw.w) + bfhi(kw.w); }
              part += __shfl_xor(part, 16); part += __shfl_xor(part, 32);
              nnew = decay * n_s[wid * 16 + li] + part; }
            __syncthreads();
#pragma unroll
            for (int nb = 0; nb < NBV; ++nb) { u32x2 o; o.x = cvt_pk(Cacc[nb][0], Cacc[nb][1]); o.y = cvt_pk(Cacc[nb][2], Cacc[nb][3]);
                *(u32x2*)(CS + swz(vblk * 16 + li, (kh * 4 + nb) * 2 + (kq >> 1)) + (kq & 1) * 8) = o; }
            if (kq == 0) n_s[wid * 16 + li] = nnew;
        }
        __syncthreads();
#undef SCAN_LOAD
#undef Q_LOAD
#undef GATE_LOAD
    }
}
__device__ void phase_scan(const Params& p, unsigned char* smem) {
    for (int rep_ = 0; rep_ < (REP_PH == 3 ? 2 : 1); ++rep_) {
        const int c = blockIdx.x;
        if (c < 128) scan_item<1>(p, smem, c >> 1, c & 1); else scan_item<0>(p, smem, 64 + (c - 128), 0);
    }
}

__device__ void panel_outb(const Params& p, int r0) {
    const int wid = threadIdx.x >> 6, lane = threadIdx.x & 63, col = (lane >> 4) * 128 + (lane & 15) * 8;
    const bf16_t* P0 = (const bf16_t*)p.ws; bf16_t* CAT0 = (bf16_t*)p.out + (size_t)MTOK * 1024;
    float gg[8], sk[8];
#pragma unroll
    for (int e = 0; e < 8; ++e) { gg[e] = p.mh_g[col + e]; sk[e] = p.skip[col + e]; }
    u32x4 pre[5];
#define OB_LOAD(it) do { const size_t r_ = (size_t)r0 + (it) * 8 + wid; const bf16_t* pr_ = P0 + r_ * LDP; \
        pre[0] = *(const u32x4*)(pr_ + col); pre[1] = *(const u32x4*)(pr_ + 512 + col); pre[2] = *(const u32x4*)(pr_ + 2048 + col); pre[3] = *(const u32x4*)(pr_ + 2560 + col); \
        pre[4] = *(const u32x4*)(CAT0 + r_ * 1024 + 512 + col); } while (0)
    OB_LOAD(0);
    for (int it = 0; it < 32; ++it) {
        const size_t r = (size_t)r0 + it * 8 + wid;
        const u32x4 hf = pre[0], hb = pre[1], ob = pre[2], zb = pre[3], xc = pre[4];
        OB_LOAD((it + 1 < 32) ? it + 1 : it);
        float hv[8], o[8], z[8], x[8];
#pragma unroll
        for (int w = 0; w < 4; ++w) { hv[2 * w] = bflo(hf[w]) + bflo(hb[w]); hv[2 * w + 1] = bfhi(hf[w]) + bfhi(hb[w]); o[2 * w] = bflo(ob[w]); o[2 * w + 1] = bfhi(ob[w]);
            z[2 * w] = bflo(zb[w]); z[2 * w + 1] = bfhi(zb[w]); x[2 * w] = bflo(xc[w]); x[2 * w + 1] = bfhi(xc[w]); }
        float s = 0.f;
#pragma unroll
        for (int e = 0; e < 8; ++e) { hv[e] *= sigm(o[e]); s += hv[e]; }
        s += __shfl_xor(s, 1); s += __shfl_xor(s, 2); s += __shfl_xor(s, 4); s += __shfl_xor(s, 8);
        const float mu = s * (1.f / 128.f); float v = 0.f;
#pragma unroll
        for (int e = 0; e < 8; ++e) { hv[e] -= mu; v += hv[e] * hv[e]; }
        v += __shfl_xor(v, 1); v += __shfl_xor(v, 2); v += __shfl_xor(v, 4); v += __shfl_xor(v, 8);
        const float rstd = rsqrtf(v * (1.f / 128.f) + 1e-5f);
        float ov[8];
#pragma unroll
        for (int e = 0; e < 8; ++e) ov[e] = (hv[e] * rstd * gg[e] + sk[e] * x[e]) * silu(z[e]);
        u32x4 w; w.x = cvt_pk(ov[0], ov[1]); w.y = cvt_pk(ov[2], ov[3]); w.z = cvt_pk(ov[4], ov[5]); w.w = cvt_pk(ov[6], ov[7]);
        *(u32x4*)(CAT0 + r * 1024 + 512 + col) = w;
    }
#undef OB_LOAD
}
template <int OUT_F32> __device__ void panel_ln(const bf16_t* Y, const float* xp, const float* xs, const float* g, const float* b, void* dst, int r0) {
    const int wid = threadIdx.x >> 6, lane = threadIdx.x & 63;
    u32x4 wy[2]; f32x4 wx[2][2];
#define LN_LOAD(it) do { const size_t r_ = (size_t)r0 + (it) * 8 + wid; const bf16_t* y_ = Y + r_ * LDP; \
        _Pragma("unroll") for (int i = 0; i < 2; ++i) { const int c_ = i * 512 + lane * 8; wy[i] = *(const u32x4*)(y_ + c_); \
            if (!OUT_F32) { const float* src_ = (r_ < NPROMPT ? xp + r_ * 1024 : xs + (r_ - NPROMPT) * 1024) + c_; wx[i][0] = __builtin_nontemporal_load((const f32x4*)src_); wx[i][1] = __builtin_nontemporal_load((const f32x4*)(src_ + 4)); } } } while (0)
    LN_LOAD(0);
    for (int it = 0; it < 32; ++it) {
        const size_t r = (size_t)r0 + it * 8 + wid;
        float v[2][8]; float s = 0.f;
#pragma unroll
        for (int i = 0; i < 2; ++i) { const u32x4 w = wy[i];
            v[i][0] = bflo(w.x); v[i][1] = bfhi(w.x); v[i][2] = bflo(w.y); v[i][3] = bfhi(w.y); v[i][4] = bflo(w.z); v[i][5] = bfhi(w.z); v[i][6] = bflo(w.w); v[i][7] = bfhi(w.w);
            if (!OUT_F32) {
#pragma unroll
                for (int e = 0; e < 4; ++e) { v[i][e] += wx[i][0][e] * ALPHA; v[i][4 + e] += wx[i][1][e] * ALPHA; } }
#pragma unroll
            for (int e = 0; e < 8; ++e) s += v[i][e]; }
        LN_LOAD((it + 1 < 32) ? it + 1 : it);
#pragma unroll
        for (int off = 1; off < 64; off <<= 1) s += __shfl_xor(s, off);
        const float mu = s * (1.f / 1024.f); float q = 0.f;
#pragma unroll
        for (int i = 0; i < 2; ++i)
#pragma unroll
            for (int e = 0; e < 8; ++e) { v[i][e] -= mu; q += v[i][e] * v[i][e]; }
#pragma unroll
        for (int off = 1; off < 64; off <<= 1) q += __shfl_xor(q, off);
        const float rstd = rsqrtf(q * (1.f / 1024.f) + 1e-5f);
#pragma unroll
        for (int i = 0; i < 2; ++i) { const int c = i * 512 + lane * 8; const f32x4 g0 = *(const f32x4*)(g + c), g1 = *(const f32x4*)(g + c + 4), b0 = *(const f32x4*)(b + c), b1 = *(const f32x4*)(b + c + 4);
            f32x4 o0, o1;
#pragma unroll
            for (int e = 0; e < 4; ++e) { o0[e] = v[i][e] * rstd * g0[e] + b0[e]; o1[e] = v[i][4 + e] * rstd * g1[e] + b1[e]; }
            if (OUT_F32) { __builtin_nontemporal_store(o0, (f32x4*)((float*)dst + r * 1024 + c)); __builtin_nontemporal_store(o1, (f32x4*)((float*)dst + r * 1024 + c + 4)); }
            else { u32x4 w; w.x = cvt_pk(o0[0], o0[1]); w.y = cvt_pk(o0[2], o0[3]); w.z = cvt_pk(o1[0], o1[1]); w.w = cvt_pk(o1[2], o1[3]); *(u32x4*)((bf16_t*)dst + r * 1024 + c) = w; } }
    }
#undef LN_LOAD
}
__device__ void panel_qknorm(const Params& p, int r0) {
    const int wid = threadIdx.x >> 6, lane = threadIdx.x & 63, sub = lane >> 4, l16 = lane & 15;
    bf16_t* P1 = (bf16_t*)p.ws;
    const int axis = l16 >> 3, f0 = (l16 & 7) * 4, d1 = axis * 64 + f0, d2 = d1 + 32;
    float inv[4];
#pragma unroll
    for (int e = 0; e < 4; ++e) inv[e] = exp2f(-(float)(f0 + e) * (13.287712379549449f / 32.f));
    for (int u = wid * 4 + sub; u < 512; u += 32) {
        const int rl = u >> 1, hh = 8 + (u & 1); const size_t r = (size_t)r0 + rl;
        const int t = (r < NPROMPT) ? (int)(r & 4095) : (int)((r - NPROMPT) & 2047);
        const float pos = (float)(axis ? (t & 63) : (t >> 6));
        bf16_t* base = P1 + r * LDP + (hh < 8 ? hh * 128 : 1024 + (hh - 8) * 128);
        const float* gn = hh < 8 ? p.qng : p.kng;
        const u32x2 w1 = *(const u32x2*)(base + d1), w2 = *(const u32x2*)(base + d2);
        float x1[4] = {bflo(w1.x), bfhi(w1.x), bflo(w1.y), bfhi(w1.y)}, x2[4] = {bflo(w2.x), bfhi(w2.x), bflo(w2.y), bfhi(w2.y)};
        float ss = 0.f;
#pragma unroll
        for (int e = 0; e < 4; ++e) ss += x1[e] * x1[e] + x2[e] * x2[e];
        ss += __shfl_xor(ss, 1); ss += __shfl_xor(ss, 2); ss += __shfl_xor(ss, 4); ss += __shfl_xor(ss, 8);
        const float rinv = rsqrtf(ss * (1.f / 128.f) + 1e-6f);
        const f32x4 g1 = *(const f32x4*)(gn + d1), g2 = *(const f32x4*)(gn + d2);
        float o1[4], o2[4];
#pragma unroll
        for (int e = 0; e < 4; ++e) { const float a = x1[e] * rinv * g1[e], bb = x2[e] * rinv * g2[e];
            const float ang = pos * inv[e]; float sn, cs; __sincosf(ang, &sn, &cs);
            o1[e] = a * cs - bb * sn; o2[e] = bb * cs + a * sn; }
        u32x2 q1, q2; q1.x = cvt_pk(o1[0], o1[1]); q1.y = cvt_pk(o1[2], o1[3]); q2.x = cvt_pk(o2[0], o2[1]); q2.y = cvt_pk(o2[2], o2[3]);
        *(u32x2*)(base + d1) = q1; *(u32x2*)(base + d2) = q2;
    }
}

namespace att {
constexpr int D = 128, NW = 8, QBLK = 32, KVBLK = 64;
constexpr float SCALE = 0.088388347648318440f, THR = 8.f;
constexpr size_t SHM_V = KVBLK * D * 2, SHM_K = KVBLK * D * 2;
#define KSWZ(row, colB) ((row) * 256 + ((colB) ^ (((row) & 15) << 4)))
#define SBAR() __builtin_amdgcn_sched_barrier(0)
__device__ __forceinline__ int crow(int r, int hi) { return (r & 3) + 8 * (r >> 2) + 4 * hi; }
__device__ __forceinline__ void partialSM(f32x16& p0, f32x16& p1, float shift) {
    if (shift != 0.f) { for (int r = 0; r < 16; ++r) { p0[r] += shift; p1[r] += shift; } }
    for (int r = 0; r < 16; ++r) p0[r] = __builtin_amdgcn_exp2f(p0[r]);
}
__device__ __forceinline__ void finishSM(f32x16& p0, f32x16& p1, float alpha, float& l_reg, bf16x8& pa0, bf16x8& pa1, bf16x8& pa2, bf16x8& pa3) {
    for (int r = 0; r < 16; ++r) p1[r] = __builtin_amdgcn_exp2f(p1[r]);
    float ps = 0; for (int r = 0; r < 16; ++r) ps += p0[r]; for (int r = 0; r < 16; ++r) ps += p1[r];
    { auto rr = __builtin_amdgcn_permlane32_swap(__float_as_uint(ps), __float_as_uint(ps), false, false);
      ps = __uint_as_float(rr[0]) + __uint_as_float(rr[1]); }
    l_reg = l_reg * alpha + ps;
#define PK4(P, BASE, OUT) do { unsigned a0 = cvt_pk(P[BASE + 0], P[BASE + 1]), a1 = cvt_pk(P[BASE + 2], P[BASE + 3]);   \
    unsigned b0 = cvt_pk(P[BASE + 4], P[BASE + 5]), b1 = cvt_pk(P[BASE + 6], P[BASE + 7]);                              \
    auto r0 = __builtin_amdgcn_permlane32_swap(a0, b0, false, false); auto r1 = __builtin_amdgcn_permlane32_swap(a1, b1, false, false); \
    u32x4 w = {r0[0], r1[0], r0[1], r1[1]}; OUT = *reinterpret_cast<bf16x8*>(&w); } while (0)
    PK4(p0, 0, pa0); PK4(p0, 8, pa1); PK4(p1, 0, pa2); PK4(p1, 8, pa3);
#undef PK4
}
__device__ __forceinline__ void qkt(f32x16& p0, f32x16& p1, const bf16_t* Ks, const bf16x8* qr, int r32, int hi) {
    p0 = f32x16{}; p1 = f32x16{};
    for (int d0 = 0; d0 < 8; ++d0) { int cb = (d0 * 16 + hi * 8) * 2;
        bf16x8 b0 = *reinterpret_cast<const bf16x8*>((const char*)Ks + KSWZ(r32, cb));
        bf16x8 b1 = *reinterpret_cast<const bf16x8*>((const char*)Ks + KSWZ(32 + r32, cb));
        p0 = __builtin_amdgcn_mfma_f32_32x32x16_bf16(b0, qr[d0], p0, 0, 0, 0);
        p1 = __builtin_amdgcn_mfma_f32_32x32x16_bf16(b1, qr[d0], p1, 0, 0, 0); }
}
__device__ __forceinline__ int v_st(int k, int c) { const int kk = (k & ~0xC) | ((k & 4) << 1) | ((k & 8) >> 1); return ((kk >> 3) * 4 + (c >> 5)) * 512 + ((kk & 7) * 32 + (c & 31)) * 2; }
__device__ __forceinline__ int v_rd_base(int lane) { return ((lane & 3) << 3) | (((lane >> 2) & 3) << 6) | (((lane >> 4) & 1) << 5) | (((lane >> 5) & 1) << 8); }
constexpr int v_rd_off(int d0, int ks, int half) { return d0 * 512 + ks * 4096 + half * 2048; }
template <int OFF> __device__ __forceinline__ s16x4 tr_read(int vb) {
    s16x4 r; asm volatile("ds_read_b64_tr_b16 %0, %1 offset:%2" : "=&v"(r) : "v"(vb), "i"(OFF) : "memory"); return r;
}
template <int D0> __device__ __forceinline__ void pv_one(f32x16& od, int vb, bf16x8 pa0, bf16x8 pa1, bf16x8 pa2, bf16x8 pa3) {
    const s16x4 l0 = tr_read<v_rd_off(D0, 0, 0)>(vb), h0 = tr_read<v_rd_off(D0, 0, 1)>(vb), l1 = tr_read<v_rd_off(D0, 1, 0)>(vb), h1 = tr_read<v_rd_off(D0, 1, 1)>(vb);
    const s16x4 l2 = tr_read<v_rd_off(D0, 2, 0)>(vb), h2 = tr_read<v_rd_off(D0, 2, 1)>(vb), l3 = tr_read<v_rd_off(D0, 3, 0)>(vb), h3 = tr_read<v_rd_off(D0, 3, 1)>(vb);
    asm volatile("s_waitcnt lgkmcnt(0)" ::: "memory"); SBAR();
#define PK(L, H) (bf16x8){L[0], L[1], L[2], L[3], H[0], H[1], H[2], H[3]}
    od = __builtin_amdgcn_mfma_f32_32x32x16_bf16(pa0, PK(l0, h0), od, 0, 0, 0);
    od = __builtin_amdgcn_mfma_f32_32x32x16_bf16(pa1, PK(l1, h1), od, 0, 0, 0);
    od = __builtin_amdgcn_mfma_f32_32x32x16_bf16(pa2, PK(l2, h2), od, 0, 0, 0);
    od = __builtin_amdgcn_mfma_f32_32x32x16_bf16(pa3, PK(l3, h3), od, 0, 0, 0);
#undef PK
}
__device__ __forceinline__ void pv_d0(f32x16* o, int vb, bf16x8 pa0, bf16x8 pa1, bf16x8 pa2, bf16x8 pa3) {
    pv_one<0>(o[0], vb, pa0, pa1, pa2, pa3); pv_one<1>(o[1], vb, pa0, pa1, pa2, pa3); pv_one<2>(o[2], vb, pa0, pa1, pa2, pa3); pv_one<3>(o[3], vb, pa0, pa1, pa2, pa3);
}
__device__ __forceinline__ void attn_body(const bf16_t* __restrict__ Qb, const bf16_t* __restrict__ Kh, const bf16_t* __restrict__ Vh, const bf16_t* __restrict__ Zb,
                                          bf16_t* __restrict__ Ob, int seq, char* lds, int tq0, const float* __restrict__ qg, const float* __restrict__ rope, float negBC) {
    constexpr int LDQ = LDP, LDK = LDP;
    int tid = threadIdx.x; asm volatile("" : "+v"(tid));
    const int wid = tid >> 6, lane = tid & 63, r32 = lane & 31, hi = lane >> 5;
    bf16_t* V_lds = (bf16_t*)lds; bf16_t* K_lds = (bf16_t*)(lds + 2 * SHM_V);
    float* ws = (float*)(lds + 2 * SHM_V + 2 * SHM_K) + wid * 64; float* li_l = ws; float* al_l = ws + 32;
    float l_reg = 0; f32x16 o[4] = {}; bf16x8 qr[8];
    const bf16_t* Qw = Qb + (long)(wid * QBLK + r32) * LDQ + hi * 8;
#pragma unroll
    for (int d0 = 0; d0 < 8; ++d0) qr[d0] = *reinterpret_cast<const bf16x8*>(Qw + d0 * 16);
    const int sr = tid >> 4, sc = (tid & 15) * 8, vst0 = v_st(sr, sc), vst1 = v_st(32 + sr, sc);
    const int vb0 = (int)(uintptr_t)V_lds + v_rd_base(lane);
    struct { bf16x8 vs0, vs1, ks0, ks1; } sr_[2];
#define LD8(P) (*reinterpret_cast<const bf16x8*>(P))
#define SLOAD(i, k0) do { sr_[i].vs0 = LD8(&Vh[(long)((k0) + sr) * LDK + sc]); sr_[i].vs1 = LD8(&Vh[(long)((k0) + 32 + sr) * LDK + sc]); \
    sr_[i].ks0 = LD8(&Kh[(long)((k0) + sr) * LDK + sc]); sr_[i].ks1 = LD8(&Kh[(long)((k0) + 32 + sr) * LDK + sc]); } while (0)
    SLOAD(0, 0); SLOAD(1, KVBLK);
    {
        float ss = 0.f; int hi_ = hi; const float* qg_ = qg;
        asm volatile("" : "+v"(hi_)); asm volatile("" : "+s"(qg_));
#pragma unroll
        for (int d0 = 0; d0 < 8; ++d0) { const u32x4 w = *reinterpret_cast<const u32x4*>(&qr[d0]);
            ss += bflo(w.x) * bflo(w.x) + bfhi(w.x) * bfhi(w.x) + bflo(w.y) * bflo(w.y) + bfhi(w.y) * bfhi(w.y) + bflo(w.z) * bflo(w.z) + bfhi(w.z) * bfhi(w.z) + bflo(w.w) * bflo(w.w) + bfhi(w.w) * bfhi(w.w); }
        ss += __shfl_xor(ss, 32);
        const float rinv = rsqrtf(ss * (1.f / 128.f) + 1e-6f) * (SCALE * 1.4426950408889634f);
        const int tpos = tq0 + wid * QBLK + r32; const float* rope_ = rope; asm volatile("" : "+s"(rope_));
#pragma unroll
        for (int ax = 0; ax < 2; ++ax)
#pragma unroll
            for (int dd = 0; dd < 2; ++dd) { const int da = ax * 4 + dd, db = da + 2;
                const u32x4 wa = *reinterpret_cast<const u32x4*>(&qr[da]), wb = *reinterpret_cast<const u32x4*>(&qr[db]);
                float xa[8] = {bflo(wa.x), bfhi(wa.x), bflo(wa.y), bfhi(wa.y), bflo(wa.z), bfhi(wa.z), bflo(wa.w), bfhi(wa.w)};
                float xb[8] = {bflo(wb.x), bfhi(wb.x), bflo(wb.y), bfhi(wb.y), bflo(wb.z), bfhi(wb.z), bflo(wb.w), bfhi(wb.w)};
                const float* ga = qg_ + da * 16 + hi_ * 8; const float* gb = qg_ + db * 16 + hi_ * 8;
                const f32x4* tp = (const f32x4*)(rope_ + ((ax ? (tpos & 63) : (tpos >> 6)) * 32 + dd * 16 + hi_ * 8) * 2);
                const f32x4 t0 = tp[0], t1 = tp[1], t2 = tp[2], t3 = tp[3];
                const float csv[8] = {t0[0], t0[2], t1[0], t1[2], t2[0], t2[2], t3[0], t3[2]}, snv[8] = {t0[1], t0[3], t1[1], t1[3], t2[1], t2[3], t3[1], t3[3]};
#pragma unroll
                for (int e = 0; e < 8; ++e) { const float x1 = xa[e] * rinv * ga[e], x2 = xb[e] * rinv * gb[e];
                    xa[e] = x1 * csv[e] - x2 * snv[e]; xb[e] = x2 * csv[e] + x1 * snv[e]; }
                u32x4 oa, ob; oa.x = cvt_pk(xa[0], xa[1]); oa.y = cvt_pk(xa[2], xa[3]); oa.z = cvt_pk(xa[4], xa[5]); oa.w = cvt_pk(xa[6], xa[7]);
                ob.x = cvt_pk(xb[0], xb[1]); ob.y = cvt_pk(xb[2], xb[3]); ob.z = cvt_pk(xb[4], xb[5]); ob.w = cvt_pk(xb[6], xb[7]);
                qr[da] = *reinterpret_cast<bf16x8*>(&oa); qr[db] = *reinterpret_cast<bf16x8*>(&ob);
                __builtin_amdgcn_sched_barrier(0); }
    }
#define SWRITE(b, i) do { *(bf16x8*)((char*)V_lds + (b) * SHM_V + vst0) = sr_[i].vs0;          \
    *(bf16x8*)((char*)V_lds + (b) * SHM_V + vst1) = sr_[i].vs1; int kc = sc * 2;               \
    *(bf16x8*)((char*)K_lds + (b) * SHM_K + KSWZ(sr, kc)) = sr_[i].ks0;                       \
    *(bf16x8*)((char*)K_lds + (b) * SHM_K + KSWZ(32 + sr, kc)) = sr_[i].ks1; } while (0)
#define SWAIT() asm volatile("s_waitcnt vmcnt(4)" ::: "memory")
#define RESC(a) do { if (__any((a) < 1.f)) { if (hi == 0) al_l[r32] = (a); asm volatile("s_waitcnt lgkmcnt(0)" ::: "memory"); \
    for (int d = 0; d < 4; ++d) for (int r = 0; r < 16; ++r) o[d][r] *= al_l[crow(r, hi)]; } } while (0)
    f32x16 pA0, pA1, pB0, pB1; bf16x8 pa0, pa1, pa2, pa3; const int NT = seq / KVBLK;
    constexpr int SE = 0, SO = 1;
    asm volatile("s_waitcnt vmcnt(0)" ::: "memory"); SWRITE(0, SE); __syncthreads();
    qkt(pA0, pA1, K_lds, qr, r32, hi); partialSM(pA0, pA1, negBC);
    SLOAD(SE, 2 * KVBLK);
    SWAIT(); SWRITE(1, SO); __syncthreads();
    if (__builtin_amdgcn_readfirstlane(tid) >= 256) __builtin_amdgcn_s_setprio(1);
    for (int j = 1; j + 1 < NT; j += 2) {
        SBAR(); qkt(pB0, pB1, (bf16_t*)((char*)K_lds + SHM_K), qr, r32, hi);
        finishSM(pA0, pA1, 1.f, l_reg, pa0, pa1, pa2, pa3); SBAR();
        SLOAD(SO, (j + 2) * KVBLK); SBAR();
        pv_d0(o, vb0, pa0, pa1, pa2, pa3); partialSM(pB0, pB1, negBC);
        __syncthreads(); SWAIT(); SWRITE(0, SE);
        __syncthreads();
        SBAR(); qkt(pA0, pA1, K_lds, qr, r32, hi);
        finishSM(pB0, pB1, 1.f, l_reg, pa0, pa1, pa2, pa3); SBAR();
        SLOAD(SE, ((j + 3 < NT) ? (j + 3) : (NT - 1)) * KVBLK); SBAR();
        pv_d0(o, vb0 + (int)SHM_V, pa0, pa1, pa2, pa3); partialSM(pA0, pA1, negBC);
        __syncthreads(); SWAIT(); SWRITE(1, SO);
        __syncthreads();
    }
    SBAR(); qkt(pB0, pB1, (bf16_t*)((char*)K_lds + SHM_K), qr, r32, hi);
    finishSM(pA0, pA1, 1.f, l_reg, pa0, pa1, pa2, pa3); SBAR();
    pv_d0(o, vb0, pa0, pa1, pa2, pa3); partialSM(pB0, pB1, negBC);
    __syncthreads();
    finishSM(pB0, pB1, 1.f, l_reg, pa0, pa1, pa2, pa3); SBAR();
    pv_d0(o, vb0 + (int)SHM_V, pa0, pa1, pa2, pa3);
    __builtin_amdgcn_s_setprio(0);
    if (hi == 0) li_l[r32] = l_reg; asm volatile("s_waitcnt lgkmcnt(0)" ::: "memory");
    float rli[16];
#pragma unroll
    for (int r = 0; r < 16; ++r) rli[r] = __builtin_amdgcn_rcpf(li_l[crow(r, hi)]);
    u32x4 zr[8];
#pragma unroll
    for (int i = 0; i < 8; ++i) { const int idx = tid + 512 * i; zr[i] = *(const u32x4*)(Zb + (long)(idx >> 4) * LDP + (idx & 15) * 8); }
    __syncthreads();
    float* Ol = (float*)lds;
#pragma unroll
    for (int r = 0; r < 16; ++r) { const int orow = wid * QBLK + crow(r, hi);
#pragma unroll
        for (int d0 = 0; d0 < 4; ++d0) Ol[orow * 132 + d0 * 32 + r32] = o[d0][r] * rli[r]; }
    __syncthreads();
#pragma unroll
    for (int i = 0; i < 8; ++i) { const int idx = tid + 512 * i, row = idx >> 4, c8 = (idx & 15) * 8;
        const f32x4 a = *(const f32x4*)(Ol + row * 132 + c8), b = *(const f32x4*)(Ol + row * 132 + c8 + 4);
        const u32x4 z = zr[i];
        u32x4 w; w.x = cvt_pk(a[0] * bflo(z.x), a[1] * bfhi(z.x)); w.y = cvt_pk(a[2] * bflo(z.y), a[3] * bfhi(z.y));
        w.z = cvt_pk(b[0] * bflo(z.z), b[1] * bfhi(z.z)); w.w = cvt_pk(b[2] * bflo(z.w), b[3] * bfhi(z.w));
        *(u32x4*)(Ob + (long)row * 1024 + c8) = w; }
    __syncthreads();
#undef LD8
#undef SLOAD
#undef SWRITE
#undef SWAIT
#undef RESC
}
}

__device__ void phase_attn(const Params& p, unsigned char* smem) {
    const bf16_t* P1 = (const bf16_t*)p.ws; bf16_t* OG = (bf16_t*)p.out + (size_t)MTOK * 1024;
    const int x = blockIdx.x & 7, wl = blockIdx.x >> 3;
    float gqm = 0.f, gkm = 0.f;
    for (int i = 0; i < 128; ++i) { gqm = fmaxf(gqm, fabsf(p.qng[i])); gkm = fmaxf(gkm, fabsf(p.kng[i])); }
    const float bound2 = (11.313708498984761f * 1.02f * gqm * gkm) * 1.4426950408889634f;
    const float negBC = bound2 > 64.f ? 64.f - bound2 : 0.f;
    for (int slot_ = 0; slot_ < (REP_PH == 5 ? 16 : 8); ++slot_) { const int slot = slot_ & 7;
        int pair, u, T, rb, hq, qb;
        if (slot < 4) { pair = x + 8 * (slot >> 1); u = wl + 32 * (slot & 1); T = 4096; rb = (pair >> 1) * 4096; hq = u >> 4; qb = u & 15; }
        else { pair = x + 8 * (slot - 4); u = wl; T = 2048; rb = NPROMPT + (pair >> 1) * 2048; hq = u >> 3; qb = u & 7; }
        const int kvh = pair & 1, hg = kvh * 4 + hq; const size_t q0 = (size_t)rb + qb * 256;
        att::attn_body(P1 + q0 * LDP + hg * 128, P1 + (size_t)rb * LDP + 1024 + kvh * 128, P1 + (size_t)rb * LDP + 1280 + kvh * 128,
                       P1 + q0 * LDP + 1536 + hg * 128, OG + q0 * 1024 + hg * 128, T, (char*)smem, qb * 256, p.qng, (const float*)(p.ws + OFF_ROPE), negBC);
    }
}


__device__ void panel_gates(const bf16_t* XB, const bf16_t* Wg  , float* gates, int r0) {
    int tid = threadIdx.x; asm volatile("" : "+v"(tid));
    const int wid = tid >> 6, lane = tid & 63, li = lane & 15, kq = lane >> 4;
    const bf16_t* xa = XB + (size_t)(r0 + (2 * wid) * 16 + li) * 1024 + kq * 8;
    const bf16_t* xb = xa + 16 * 1024;
    const bf16_t* wp = Wg + (size_t)li * 1024 + kq * 8;
    f32x4 acc0 = {0.f, 0.f, 0.f, 0.f}, acc1 = {0.f, 0.f, 0.f, 0.f};
    for (int kc = 0; kc < 4; ++kc) {
        bf16x8 wf[8], x0[8], x1[8];
#pragma unroll
        for (int u = 0; u < 8; ++u) { const int ko = (kc * 8 + u) * 32; wf[u] = *(const bf16x8*)(wp + ko); x0[u] = *(const bf16x8*)(xa + ko); x1[u] = *(const bf16x8*)(xb + ko); }
#pragma unroll
        for (int u = 0; u < 8; ++u) { acc0 = __builtin_amdgcn_mfma_f32_16x16x32_bf16(wf[u], x0[u], acc0, 0, 0, 0); acc1 = __builtin_amdgcn_mfma_f32_16x16x32_bf16(wf[u], x1[u], acc1, 0, 0, 0); }
    }
    *(f32x4*)(gates + (size_t)(r0 + (2 * wid) * 16 + li) * 16 + kq * 4) = acc0;
    *(f32x4*)(gates + (size_t)(r0 + (2 * wid + 1) * 16 + li) * 16 + kq * 4) = acc1;
}

#define XB_TMO      128
#define XB_XCNT(j)  (256  + 64 * (j))
#define XB_XSUB(j)  (1280 + 64 * (j))
#define XB_XGEN(j)  (2304 + 64 * (j))
#define XB_TOP      3328
#define XB_TOPGEN   3392
#define XCD_BAR_WORDS 3456
#define XB_SPIN_CAP (1u << 18)
__device__ __forceinline__ unsigned xb_ld(unsigned* p)              { return __hip_atomic_load(p, __ATOMIC_RELAXED, __HIP_MEMORY_SCOPE_AGENT); }
__device__ __forceinline__ unsigned xb_add(unsigned* p, unsigned v) { return __hip_atomic_fetch_add(p, v, __ATOMIC_RELAXED, __HIP_MEMORY_SCOPE_AGENT); }
__device__ __forceinline__ unsigned xb_xcc_id() { return (unsigned)__builtin_amdgcn_s_getreg((3 << 11) | 20) & 0xFu; }
#define XB_SPIN(cond, bar) do { unsigned _sp = 0; while (cond) { __builtin_amdgcn_s_sleep(1); \
    if ((++_sp & 255u) == 0u) { if (xb_ld(&(bar)[XB_TMO])) break; if (_sp > XB_SPIN_CAP) { atomicAdd(&(bar)[XB_TMO], 1u); break; } } } } while (0)
struct XcdBarrier { unsigned* bar; unsigned x; volatile LAS unsigned* st; };
__device__ __forceinline__ XcdBarrier xcd_barrier_post(unsigned* bar, volatile LAS unsigned* st) {
    XcdBarrier b; b.bar = bar; b.x = xb_xcc_id(); b.st = st;
    if (threadIdx.x == 0) (void)xb_add(&bar[XB_XCNT(b.x)], 1u);
    return b;
}
__device__ __forceinline__ void xcd_barrier_complete(unsigned* bar, unsigned x, unsigned& nloc, unsigned& nx) {
    const unsigned G = gridDim.x * gridDim.y * gridDim.z;
    unsigned sum, cnt, mine, sp = 0u;
    for (;;) {
        sum = 0u; cnt = 0u; mine = 0u;
#pragma unroll
        for (unsigned j = 0; j < 16; ++j) { const unsigned c = xb_ld(&bar[XB_XCNT(j)]); sum += c; cnt += (c > 0u) ? 1u : 0u; mine = (j == x) ? c : mine; }
        if (sum == G) break;
        __builtin_amdgcn_s_sleep(1);
        if ((++sp & 255u) == 0u) { if (xb_ld(&bar[XB_TMO])) break; if (sp > XB_SPIN_CAP) { atomicAdd(&bar[XB_TMO], 1u); break; } }
    }
    nloc = mine > 0u ? mine : 1u; nx = cnt > 0u ? cnt : 1u;
}
__device__ __forceinline__ void xcd_barrier(const XcdBarrier& b) {
    asm volatile("s_waitcnt vmcnt(0)" ::: "memory");
    __syncthreads();
    if (threadIdx.x == 0) {
        unsigned* bar = b.bar;
        __builtin_amdgcn_s_waitcnt(0);
        unsigned nloc = b.st[0], nx = b.st[1];
        if (nloc == 0u) { xcd_barrier_complete(bar, b.x, nloc, nx); b.st[0] = nloc; b.st[1] = nx; }
        const unsigned old = xb_add(&bar[XB_XSUB(b.x)], 1u);
        const unsigned gen = old / nloc;
        if (old + 1u == (gen + 1u) * nloc) {
            __builtin_amdgcn_fence(__ATOMIC_RELEASE, "agent");
            asm volatile("s_waitcnt vmcnt(0)" ::: "memory");
            const unsigned og = xb_add(&bar[XB_TOP], 1u);
            const unsigned tg = og / nx;
            if (og + 1u == (tg + 1u) * nx) xb_add(&bar[XB_TOPGEN], 1u);
            else XB_SPIN(xb_ld(&bar[XB_TOPGEN]) == tg, bar);
            __builtin_amdgcn_fence(__ATOMIC_ACQUIRE, "agent");
            xb_add(&bar[XB_XGEN(b.x)], 1u);
            asm volatile("s_waitcnt vmcnt(0)" ::: "memory");
        } else {
            XB_SPIN(xb_ld(&bar[XB_XGEN(b.x)]) == gen, bar);
            __builtin_amdgcn_fence(__ATOMIC_ACQUIRE, "agent");
            asm volatile("s_waitcnt vmcnt(0)" ::: "memory");
        }
    }
    __syncthreads();
}

__global__ __launch_bounds__(512, 2) void mk_fwd(Params p) {
    extern __shared__ __attribute__((aligned(16))) unsigned char smem[];
    cg::grid_group grid = cg::this_grid();
    LAS unsigned char* lds = (LAS unsigned char*)smem;
    bf16_t* P0 = (bf16_t*)p.ws; float* Y = (float*)p.ws;
    bf16_t* XB = (bf16_t*)p.out; bf16_t* CAT0 = XB + (size_t)MTOK * 1024;
#ifndef ONLY_PH
#define ONLY_PH -1
#endif
#define RUN(n) (p.ph_lo <= (n) && (n) < p.ph_hi && (ONLY_PH < 0 || ONLY_PH == (n)))
#define REPEAT(n) for (int rep_ = 0; rep_ < ((REP_PH == (n)) ? 2 : 1); ++rep_)
#define SYNC(n) do { if (p.ph_lo <= (n) && (n) + 1 < p.ph_hi) { if ((n) == 0 || MK_MULTI) { grid.sync(); if ((n) == 0) xb = xcd_barrier_post((unsigned*)(p.ws + OFF_BAR), xst); } else xcd_barrier(xb); } } while (0)
    volatile LAS unsigned* xst = (volatile LAS unsigned*)(lds + (LDS_BYTES - 16));
    if (threadIdx.x == 0) { xst[0] = 0u; xst[1] = 0u; }
    __syncthreads();
    XcdBarrier xb; xb.bar = (unsigned*)(p.ws + OFF_BAR); xb.x = 0u; xb.st = xst;
    if (RUN(0)) phase_prep(p, smem);
    if (REP_PH == 0) { grid.sync(); phase_prep(p, smem); }
    SYNC(0);
    if (REP_PH == 13) { grid.sync(); grid.sync(); grid.sync(); grid.sync(); }
    if (RUN(1)) {
        pg8::PanelOrder S{(int)blockIdx.x, 12};
        pg8::EpiP0 E{P0, (float*)(p.ws + OFF_GATES)};
        pg8::gemm_phase(lds, pg8::Gemm{XB, (const bf16_t*)(p.ws + OFF_WT0), MTOK, 3072, 1024, 1024}, S, E);
        panel_gates(XB, (const bf16_t*)(p.ws + OFF_WT0) + (size_t)3072 * 1024, (float*)(p.ws + OFF_GATES), (int)blockIdx.x * 256);
    }
    SYNC(1);
    if (RUN(2)) phase_mix(p, smem);
    SYNC(2);
    if (RUN(3)) phase_scan(p, smem);
    SYNC(3);
    if (RUN(4)) {
        const int pm = blockIdx.x, r0 = pm * 256;
        panel_outb(p, r0);
        __builtin_amdgcn_fence(__ATOMIC_SEQ_CST, "workgroup"); __syncthreads();
        { pg8::PanelOrder S{pm, 4}; pg8::EpiRes<0> E{P0, nullptr};
          pg8::gemm_phase(lds, pg8::Gemm{CAT0, (const bf16_t*)(p.ws + OFF_WO0T), MTOK, 1024, 1024, 1024}, S, E); }
        __builtin_amdgcn_fence(__ATOMIC_SEQ_CST, "workgroup"); __syncthreads();
        panel_ln<0>(P0, p.xp, p.xs, p.ln_g, p.ln_b, XB, r0);
        __builtin_amdgcn_fence(__ATOMIC_SEQ_CST, "workgroup"); __syncthreads();
        { pg8::PanelOrder S{pm, 10}; pg8::EpiBf E{P0};
          pg8::gemm_phase(lds, pg8::Gemm{XB, (const bf16_t*)(p.ws + OFF_WT1), MTOK, 2560, 1024, 1024}, S, E); }
        __builtin_amdgcn_fence(__ATOMIC_SEQ_CST, "workgroup"); __syncthreads();
        panel_qknorm(p, r0);
    }
    SYNC(4);
    if (RUN(5)) phase_attn(p, smem);
    SYNC(5);
    if (RUN(6)) {
        pg8::PanelOrder S{(int)blockIdx.x, 4}; pg8::EpiRes<1> E{P0, XB};
        pg8::gemm_phase(lds, pg8::Gemm{CAT0, (const bf16_t*)(p.ws + OFF_WO1T), MTOK, 1024, 1024, 1024}, S, E);
    }
    SYNC(6);
    if (RUN(7)) panel_ln<1>(P0, nullptr, nullptr, p.ln_g + 1024, p.ln_b + 1024, p.out, (int)blockIdx.x * 256);
}

extern "C" void kernel_launch(void* const* d_in, const int* in_sizes, int n_in, void* d_out, int out_size, void* d_ws, size_t ws_size, hipStream_t stream) {
    static int ok = 0;
    if (ok == 0) {
        if (n_in != 20 || out_size != MTOK * DM || ws_size < WS_END) { fprintf(stderr, "kernel_launch: unexpected shapes n_in %d out %d ws %zu (need %zu)\n", n_in, out_size, ws_size, (size_t)WS_END); ok = -1; return; }
        if (hipFuncSetAttribute((const void*)mk_fwd, hipFuncAttributeMaxDynamicSharedMemorySize, LDS_BYTES) != hipSuccess) { fprintf(stderr, "kernel_launch: hipFuncSetAttribute failed\n"); ok = -1; return; }
        int dev = 0, cus = 0, per_cu = 0;
        hipGetDevice(&dev); hipDeviceGetAttribute(&cus, hipDeviceAttributeMultiprocessorCount, dev);
        hipOccupancyMaxActiveBlocksPerMultiprocessor(&per_cu, (const void*)mk_fwd, 512, LDS_BYTES);
        if (cus * per_cu < 256) { fprintf(stderr, "kernel_launch: %d CUs x %d blocks cannot hold the 256-workgroup grid\n", cus, per_cu); ok = -1; return; }
        ok = 1;
    }
    if (ok < 0) return;
    Params p{};
    p.xp = (const float*)d_in[0]; p.xs = (const float*)d_in[1]; p.w_in_even = (const float*)d_in[2]; p.w_pool = (const float*)d_in[3]; p.pool_scale = (const float*)d_in[4];
    p.conv_w = (const float*)d_in[5]; p.conv_b = (const float*)d_in[6]; p.w_q = (const float*)d_in[7]; p.w_k = (const float*)d_in[8]; p.bgi = (const float*)d_in[9];
    p.bgf = (const float*)d_in[10]; p.mh_g = (const float*)d_in[11]; p.skip = (const float*)d_in[12]; p.w_out_even = (const float*)d_in[13]; p.w_in_odd = (const float*)d_in[14];
    p.qng = (const float*)d_in[15]; p.kng = (const float*)d_in[16]; p.w_out_odd = (const float*)d_in[17]; p.ln_g = (const float*)d_in[18]; p.ln_b = (const float*)d_in[19];
    p.out = (float*)d_out; p.ws = (unsigned char*)d_ws;
#if MK_MULTI
    for (int ph = 0; ph < 8; ++ph) { p.ph_lo = ph; p.ph_hi = ph + 1; void* args[] = {&p};
        hipError_t e = hipLaunchCooperativeKernel((const void*)mk_fwd, dim3(256), dim3(512), args, LDS_BYTES, stream);
        if (e != hipSuccess) { fprintf(stderr, "kernel_launch: launch %d failed: %s\n", ph, hipGetErrorString(e)); return; } }
#else
    p.ph_lo = 0; p.ph_hi = 8; void* args[] = {&p};
    hipError_t e = hipLaunchCooperativeKernel((const void*)mk_fwd, dim3(256), dim3(512), args, LDS_BYTES, stream);
    if (e != hipSuccess) fprintf(stderr, "kernel_launch: cooperative launch failed: %s\n", hipGetErrorString(e));
#endif
}
```

```cpp
#include <hip/hip_runtime.h>
#include <hip/hip_cooperative_groups.h>
#include <cstdio>
namespace cg = cooperative_groups;

#ifndef MK_MULTI
#define MK_MULTI 0
#endif

#ifndef REP_PH
#define REP_PH -1
#endif
typedef unsigned short bf16_t;
typedef short bf16x8 __attribute__((ext_vector_type(8)));
typedef short s16x4 __attribute__((ext_vector_type(4)));
typedef float f32x4 __attribute__((ext_vector_type(4)));
typedef float f32x16 __attribute__((ext_vector_type(16)));
typedef unsigned u32x4 __attribute__((ext_vector_type(4)));
typedef unsigned u32x2 __attribute__((ext_vector_type(2)));
#define LAS __attribute__((address_space(3)))

constexpr int MTOK = 65536, NPROMPT = 32768, DM = 1024;
constexpr int LDP = 3072;
constexpr size_t P0_BYTES = (size_t)MTOK * LDP * 2;
constexpr size_t OFF_WT0 = P0_BYTES;
constexpr size_t OFF_WO0T = OFF_WT0 + (size_t)3328 * 1024 * 2;
constexpr size_t OFF_WT1 = OFF_WO0T + (size_t)1024 * 1024 * 2;
constexpr size_t OFF_WO1T = OFF_WT1 + (size_t)2560 * 1024 * 2;
constexpr size_t OFF_WPT = OFF_WO1T + (size_t)1024 * 1024 * 2;
constexpr size_t OFF_WQT = OFF_WPT + 131072;
constexpr size_t OFF_WKT = OFF_WQT + 131072;
constexpr size_t OFF_GATES = OFF_WKT + 131072;
constexpr size_t OFF_BAR = OFF_GATES + (size_t)MTOK * 16 * 4;
constexpr size_t OFF_SCR = OFF_BAR + 3456 * 4;
constexpr int SCR_ITEM = 32 * 384 + 64;
constexpr size_t OFF_ROPE = OFF_SCR + (size_t)192 * SCR_ITEM * 4;
constexpr size_t WS_END = OFF_ROPE + 64 * 32 * 2 * 4;
constexpr int LDS_BYTES = 136 * 1024;
constexpr float ALPHA = 1.41421356237309515f;

struct Params {
    const float* xp; const float* xs; const float* w_in_even; const float* w_pool; const float* pool_scale; const float* conv_w; const float* conv_b;
    const float* w_q; const float* w_k; const float* bgi; const float* bgf; const float* mh_g; const float* skip; const float* w_out_even;
    const float* w_in_odd; const float* qng; const float* kng; const float* w_out_odd; const float* ln_g; const float* ln_b;
    float* out; unsigned char* ws; int ph_lo, ph_hi;
};

__device__ __forceinline__ unsigned cvt_pk(float lo, float hi) { unsigned r; asm volatile("v_cvt_pk_bf16_f32 %0, %1, %2" : "=v"(r) : "v"(lo), "v"(hi)); return r; }
__device__ __forceinline__ float bflo(unsigned w) { return __uint_as_float(w << 16); }
__device__ __forceinline__ float bfhi(unsigned w) { return __uint_as_float(w & 0xffff0000u); }
__device__ __forceinline__ bf16_t f2bf(float f) { unsigned u = __float_as_uint(f); u += 0x7FFFu + ((u >> 16) & 1u); return (bf16_t)(u >> 16); }
__device__ __forceinline__ float sigm(float x) { return __builtin_amdgcn_rcpf(1.f + __expf(-x)); }
__device__ __forceinline__ float silu(float x) { return x * sigm(x); }
__device__ __forceinline__ int swz(int row, int chunk) { return row * 256 + ((chunk ^ (row & 15)) << 4); }

namespace pg8 {
constexpr int BM = 256, BK = 64, HALF = 128, HTB = HALF * BK * 2, STAGE_BYTES = 8 * HTB;
__device__ __forceinline__ int lds_byte(int r, int c) { const int st = (r >> 4) * 2 + (c >> 5), rr = r & 15, cc = c & 31, ob = rr * 64 + cc * 2; return st * 1024 + (ob ^ (((ob >> 9) & 1) << 5)); }
__device__ __forceinline__ void stage_rc(int b, int& R, int& C) { const int st = b / 1024, sb = b % 1024, sw = sb ^ (((sb >> 9) & 1) << 5); R = (st >> 1) * 16 + sw / 64; C = (st & 1) * 32 + (sw % 64) / 2; }
__device__ __forceinline__ int perm32(int rho) { const int n = rho >> 4, i = rho & 15; return 8 * (i >> 2) + 4 * n + (i & 3); }
struct Unit { int pm, pn; };
struct Gemm { const bf16_t* A; const bf16_t* Bt; int M, N, K, lda; };
struct StaticOrder {
    int nM, nN, nwg, G, c;
    __device__ void init(int M, int N, int G_, int c_) { nM = M / BM; nN = N / BM; nwg = nM * nN; G = G_; c = c_; }
    __device__ bool next(int i, Unit& u) const {
        if (REP_PH == 1 && i >= 13 && i < 26) i -= 13;
        const long L = (long)i * G + c; if (L >= nwg) return false;
        int wgid = (int)L; { const int q = nwg / 8, r = nwg % 8, xcd = wgid % 8, off = wgid / 8; wgid = (xcd < r ? xcd * (q + 1) : r * (q + 1) + (xcd - r) * q) + off; }
        const int nig = 8 * nN, gid = wgid / nig, fm = gid * 8, gsz = (nM - fm) < 8 ? (nM - fm) : 8;
        u.pm = fm + ((wgid % nig) % gsz); u.pn = (wgid % nig) / gsz; return true;
    }
};
struct PanelOrder {
    int pm, nN;
    __device__ bool next(int i, Unit& u) const { if (REP_PH == 12 && nN == 4) { if (i >= 8) return false; u.pm = pm; u.pn = i & 3; return true; }
        if (i >= nN) return false; u.pm = pm; u.pn = i; return true; }
};

template <class Epi, class Sched>
__device__ __forceinline__ void gemm_phase(LAS unsigned char* lds, const Gemm g, const Sched& S, const Epi& E) {
    int tid = threadIdx.x; asm volatile("" : "+v"(tid));
    const int wid = __builtin_amdgcn_readfirstlane(tid >> 6), lane = tid & 63, wr = wid >> 2, wc = wid & 3, fr = lane & 15, fq = lane >> 4;
    const int K = g.K, nt = K / BK, lda = g.lda;
    unsigned voffA[2], voffB[2];
#pragma unroll
    for (int i = 0; i < 2; ++i) { int R, C; stage_rc(tid * 16 + i * 8192, R, C); const int Rb = Epi::PERM ? ((R & ~31) + perm32(R & 31)) : R;
        voffA[i] = (unsigned)(R * lda + C) * 2u; voffB[i] = (unsigned)(Rb * K + C) * 2u; }
    const size_t kstep = (size_t)(BK * 2);
    const size_t hA = (size_t)HALF * lda * 2, hB = (size_t)HALF * K * 2;
    const size_t tA = 2 * hA, tB = 2 * hB;
    const unsigned ldsw = (unsigned)wid * 1024u;
    const int aoff = lds_byte(wr * 64 + fr, fq * 8), boff = lds_byte(wc * 32 + fr, fq * 8);
#define PG8_SA(b, h) (((b) * 2 + (h)) * HTB)
#define PG8_SB(b, h) ((4 + (b) * 2 + (h)) * HTB)
#define PG8_STAGE(bufoff, gbase, voff) do { const char* _gb = (const char*)(gbase); asm volatile("" : "+s"(_gb)); _Pragma("unroll") for (int _i = 0; _i < 2; ++_i) \
        __builtin_amdgcn_global_load_lds((const unsigned*)(_gb + (voff)[_i]), (LAS unsigned*)(lds + (bufoff) + ldsw + _i * 8192), 16, 0, 0); } while (0)
#define PG8_LDA(dst, b, h) do { _Pragma("unroll") for (int m = 0; m < 4; ++m) _Pragma("unroll") for (int k = 0; k < 2; ++k) dst[m][k] = *(const LAS bf16x8*)(lds + PG8_SA(b, h) + aoff + m * 2048 + k * 1024); } while (0)
#define PG8_LDB(dst, b, h) do { _Pragma("unroll") for (int n = 0; n < 2; ++n) _Pragma("unroll") for (int k = 0; k < 2; ++k) dst[n][k] = *(const LAS bf16x8*)(lds + PG8_SB(b, h) + boff + n * 2048 + k * 1024); } while (0)
#define PG8_MMA(ai, bj, At, Bt) do { __builtin_amdgcn_s_setprio(1); _Pragma("unroll") for (int m = 0; m < 4; ++m) _Pragma("unroll") for (int n = 0; n < 2; ++n) _Pragma("unroll") for (int k = 0; k < 2; ++k) \
        acc[ai][bj][m][n] = __builtin_amdgcn_mfma_f32_16x16x32_bf16(Bt[n][k], At[m][k], acc[ai][bj][m][n], 0, 0, 0); __builtin_amdgcn_s_setprio(0); } while (0)
#define PG8_WAIT_V(n) asm volatile("s_waitcnt vmcnt(" #n ")" ::: "memory")
#define PG8_WAIT_L(n) asm volatile("s_waitcnt lgkmcnt(" #n ")" ::: "memory")
#define PG8_BAR __builtin_amdgcn_s_barrier()
#define PG8_SCHED __builtin_amdgcn_sched_barrier(0)
    Unit cur, nxt; int ui = 0;
    if (!S.next(0, cur)) return;
    f32x4 acc[2][2][4][2];
#pragma unroll
    for (int a = 0; a < 2; ++a)
#pragma unroll
        for (int b = 0; b < 2; ++b)
#pragma unroll
            for (int m = 0; m < 4; ++m)
#pragma unroll
                for (int n = 0; n < 2; ++n) acc[a][b][m][n] = (f32x4){0.f, 0.f, 0.f, 0.f};
    bf16x8 At[4][2], B0[2][2], B1[2][2];
    const char* cA = (const char*)g.A + (size_t)cur.pm * tA; const char* cB = (const char*)g.Bt + (size_t)cur.pn * tB;
    PG8_STAGE(PG8_SB(0, 0), cB, voffB); PG8_STAGE(PG8_SA(0, 0), cA, voffA); PG8_STAGE(PG8_SB(0, 1), cB + hB, voffB); PG8_STAGE(PG8_SA(0, 1), cA + hA, voffA);
    if (wr == 1) PG8_BAR;
    PG8_WAIT_V(4); PG8_BAR;
    PG8_STAGE(PG8_SB(1, 0), cB + kstep, voffB); PG8_STAGE(PG8_SA(1, 0), cA + kstep, voffA); PG8_STAGE(PG8_SB(1, 1), cB + hB + kstep, voffB);
    PG8_WAIT_V(6); PG8_BAR;
    for (;;) {
        const bool has_next = S.next(ui + 1, nxt);
        const char* nA = has_next ? (const char*)g.A + (size_t)nxt.pm * tA : cA; const char* nB = has_next ? (const char*)g.Bt + (size_t)nxt.pn * tB : cB;
        for (int t = 0; t < nt; t += 2) {
            const bool last = (t == nt - 2);
            const char* a1 = cA + (size_t)(t + 1) * kstep;
            const char* a2 = last ? nA : cA + (size_t)(t + 2) * kstep; const char* b2 = last ? nB : cB + (size_t)(t + 2) * kstep;
            const char* a3 = a2 + kstep; const char* b3 = b2 + kstep;
            PG8_LDB(B0, 0, 0); PG8_SCHED; PG8_LDA(At, 0, 0); PG8_STAGE(PG8_SA(1, 1), a1 + hA, voffA);
            PG8_WAIT_L(8); PG8_BAR; PG8_WAIT_L(0); PG8_MMA(0, 0, At, B0); PG8_BAR; PG8_SCHED;
            PG8_LDB(B1, 0, 1); PG8_STAGE(PG8_SB(0, 0), b2, voffB);
            PG8_BAR; PG8_WAIT_L(0); PG8_MMA(0, 1, At, B1); PG8_BAR;
            PG8_LDA(At, 0, 1); PG8_STAGE(PG8_SA(0, 0), a2, voffA);
            PG8_BAR; PG8_WAIT_L(0); PG8_MMA(1, 0, At, B0); PG8_BAR; PG8_SCHED;
            PG8_STAGE(PG8_SB(0, 1), b2 + hB, voffB);
            PG8_WAIT_V(6); PG8_BAR; PG8_MMA(1, 1, At, B1); PG8_BAR;
            PG8_LDB(B0, 1, 0); PG8_SCHED; PG8_LDA(At, 1, 0); PG8_STAGE(PG8_SA(0, 1), a2 + hA, voffA);
            PG8_WAIT_L(8); PG8_BAR; PG8_WAIT_L(0); PG8_MMA(0, 0, At, B0); PG8_BAR; PG8_SCHED;
            PG8_LDB(B1, 1, 1); PG8_STAGE(PG8_SB(1, 0), b3, voffB);
            PG8_BAR; PG8_WAIT_L(0); PG8_MMA(0, 1, At, B1); PG8_BAR;
            PG8_LDA(At, 1, 1); PG8_STAGE(PG8_SA(1, 0), a3, voffA);
            PG8_BAR; PG8_WAIT_L(0); PG8_MMA(1, 0, At, B0); PG8_BAR; PG8_SCHED;
            PG8_STAGE(PG8_SB(1, 1), b3 + hB, voffB);
            PG8_WAIT_V(6); PG8_BAR; PG8_MMA(1, 1, At, B1); PG8_BAR;
        }
        E(acc, cur, wr, wc, fr, fq);
        if (!has_next) break;
#pragma unroll
        for (int a = 0; a < 2; ++a)
#pragma unroll
            for (int b = 0; b < 2; ++b)
#pragma unroll
                for (int m = 0; m < 4; ++m)
#pragma unroll
                    for (int n = 0; n < 2; ++n) acc[a][b][m][n] = (f32x4){0.f, 0.f, 0.f, 0.f};
        cur = nxt; cA = nA; cB = nB; ++ui;
    }
    PG8_WAIT_V(0);
    if (wr == 0) PG8_BAR;
    PG8_BAR;
#undef PG8_SA
#undef PG8_SB
#undef PG8_STAGE
#undef PG8_LDA
#undef PG8_LDB
#undef PG8_MMA
#undef PG8_WAIT_V
#undef PG8_WAIT_L
#undef PG8_BAR
#undef PG8_SCHED
}

struct EpiP0 {
    static constexpr bool PERM = true;
    bf16_t* P0; float* gates;
    __device__ __forceinline__ void operator()(const f32x4 (&acc)[2][2][4][2], const Unit& u, int wr, int wc, int fr, int fq) const {
        const int row0 = u.pm * BM + wr * 64 + fr;
        if (u.pn < 12) {
            const int col0 = u.pn * BM + wc * 32 + 8 * fq;
#pragma unroll
            for (int ai = 0; ai < 2; ++ai)
#pragma unroll
                for (int m = 0; m < 4; ++m) { bf16_t* rowp = P0 + (size_t)(row0 + ai * HALF + m * 16) * LDP + col0;
#pragma unroll
                    for (int bj = 0; bj < 2; ++bj) { const f32x4 v0 = acc[ai][bj][m][0], v1 = acc[ai][bj][m][1];
                        u32x4 w; w.x = cvt_pk(v0[0], v0[1]); w.y = cvt_pk(v0[2], v0[3]); w.z = cvt_pk(v1[0], v1[1]); w.w = cvt_pk(v1[2], v1[3]);
                        *(u32x4*)(rowp + bj * HALF) = w; } }
        } else if (wc == 0 && fq < 2) {
#pragma unroll
            for (int ai = 0; ai < 2; ++ai)
#pragma unroll
                for (int m = 0; m < 4; ++m) { float* gp = gates + (size_t)(row0 + ai * HALF + m * 16) * 16 + 8 * fq;
                    *(f32x4*)gp = acc[ai][0][m][0]; *(f32x4*)(gp + 4) = acc[ai][0][m][1]; }
        }
    }
};
struct EpiBf {
    static constexpr bool PERM = true;
    bf16_t* O;
    __device__ __forceinline__ void operator()(const f32x4 (&acc)[2][2][4][2], const Unit& u, int wr, int wc, int fr, int fq) const {
        const int row0 = u.pm * BM + wr * 64 + fr, col0 = u.pn * BM + wc * 32 + 8 * fq; const bool gate = u.pn >= 6;
#pragma unroll
        for (int ai = 0; ai < 2; ++ai)
#pragma unroll
            for (int m = 0; m < 4; ++m) { bf16_t* rowp = O + (size_t)(row0 + ai * HALF + m * 16) * LDP + col0;
#pragma unroll
                for (int bj = 0; bj < 2; ++bj) { f32x4 v0 = acc[ai][bj][m][0], v1 = acc[ai][bj][m][1];
                    if (gate) {
#pragma unroll
                        for (int e = 0; e < 4; ++e) { v0[e] = silu(v0[e]); v1[e] = silu(v1[e]); } }
                    u32x4 w; w.x = cvt_pk(v0[0], v0[1]); w.y = cvt_pk(v0[2], v0[3]); w.z = cvt_pk(v1[0], v1[1]); w.w = cvt_pk(v1[2], v1[3]);
                    *(u32x4*)(rowp + bj * HALF) = w; } }
    }
};
template <int RES_BF16> struct EpiRes {
    static constexpr bool PERM = true;
    bf16_t* Y; const bf16_t* xb;
    __device__ __forceinline__ void operator()(const f32x4 (&acc)[2][2][4][2], const Unit& u, int wr, int wc, int fr, int fq) const {
        const int row0 = u.pm * BM + wr * 64 + fr, col0 = u.pn * BM + wc * 32 + 8 * fq;
#pragma unroll
        for (int ai = 0; ai < 2; ++ai) {
            u32x4 res[4][2];
            if (RES_BF16) {
#pragma unroll
                for (int m = 0; m < 4; ++m)
#pragma unroll
                    for (int bj = 0; bj < 2; ++bj) res[m][bj] = *(const u32x4*)(xb + (size_t)(row0 + ai * HALF + m * 16) * 1024 + col0 + bj * HALF);
            }
#pragma unroll
            for (int m = 0; m < 4; ++m) { const int row = row0 + ai * HALF + m * 16; bf16_t* yp = Y + (size_t)row * LDP + col0;
#pragma unroll
                for (int bj = 0; bj < 2; ++bj) { f32x4 v0 = acc[ai][bj][m][0], v1 = acc[ai][bj][m][1];
                    if (RES_BF16) { const u32x4 w = res[m][bj];
                        v0 += (f32x4){bflo(w.x), bfhi(w.x), bflo(w.y), bfhi(w.y)} * ALPHA; v1 += (f32x4){bflo(w.z), bfhi(w.z), bflo(w.w), bfhi(w.w)} * ALPHA; }
                    u32x4 o; o.x = cvt_pk(v0[0], v0[1]); o.y = cvt_pk(v0[2], v0[3]); o.z = cvt_pk(v1[0], v1[1]); o.w = cvt_pk(v1[2], v1[3]);
                    *(u32x4*)(yp + bj * HALF) = o; } }
            __builtin_amdgcn_sched_barrier(0);
        }
    }
};
}

template <int NB> __device__ __forceinline__ void mm16(f32x4 (&acc)[NB], const unsigned char* Xs, const bf16x8 (&yf)[4], int lane) {
    const int i = lane & 15, kq = lane >> 4;
#pragma unroll
    for (int ks = 0; ks < 4; ++ks)
#pragma unroll
        for (int nb = 0; nb < NB; ++nb) {
            const bf16x8 x = *(const bf16x8*)(Xs + swz(nb * 16 + i, ks * 4 + kq));
            acc[nb] = __builtin_amdgcn_mfma_f32_16x16x32_bf16(x, yf[ks], acc[nb], 0, 0, 0);
            if ((nb & 3) == 3) __builtin_amdgcn_sched_barrier(0);
        }
}
__device__ __forceinline__ void ldfrag(bf16x8 (&f)[4], const unsigned char* Ts, int rb, int lane) {
#pragma unroll
    for (int ks = 0; ks < 4; ++ks) f[ks] = *(const bf16x8*)(Ts + swz(rb * 16 + (lane & 15), ks * 4 + (lane >> 4)));
}
__device__ __forceinline__ void stage_tile(unsigned char* dst, const bf16_t* src, int ld) {
    for (int idx = threadIdx.x; idx < 2048; idx += 512) { const int row = idx >> 4, ch = idx & 15;
        *(u32x4*)(dst + swz(row, ch)) = *(const u32x4*)(src + (size_t)row * ld + ch * 8); }
}

__device__ void phase_prep(const Params& p, unsigned char* smem) {
    const int tid = threadIdx.x;
    if (blockIdx.x == 0) for (int i = tid; i < 3456; i += 512) ((unsigned*)(p.ws + OFF_BAR))[i] = 0u;
    if (blockIdx.x == 1) for (int i = tid; i < 2048; i += 512) { const float inv = exp2f(-(float)(i & 31) * (13.287712379549449f / 32.f)); float sn, cs; __sincosf((float)(i >> 5) * inv, &sn, &cs);
        ((float2*)(p.ws + OFF_ROPE))[i] = make_float2(cs, sn); }
    bf16_t* XB = (bf16_t*)p.out;
    const size_t n8 = (size_t)MTOK * DM / 8, half8 = (size_t)NPROMPT * DM / 8;
    for (size_t i = (size_t)blockIdx.x * 512 + tid; i < n8; i += (size_t)gridDim.x * 512) {
        const float* src = i < half8 ? p.xp + i * 8 : p.xs + (i - half8) * 8;
        const f32x4 a = __builtin_nontemporal_load((const f32x4*)src), b = __builtin_nontemporal_load((const f32x4*)(src + 4));
        u32x4 w; w.x = cvt_pk(a[0], a[1]); w.y = cvt_pk(a[2], a[3]); w.z = cvt_pk(b[0], b[1]); w.w = cvt_pk(b[2], b[3]);
        *(u32x4*)(XB + i * 8) = w;
    }
    float* t = (float*)smem;
    for (int ti = blockIdx.x; ti < 2032; ti += gridDim.x) {
        const float* src; bf16_t* dst; int K, N, tn, li; float scale = 1.f;
        if (ti < 832) { src = p.w_in_even; dst = (bf16_t*)(p.ws + OFF_WT0); K = 1024; N = 3088; tn = 52; li = ti; }
        else if (ti < 1088) { src = p.w_out_even; dst = (bf16_t*)(p.ws + OFF_WO0T); K = 1024; N = 1024; tn = 16; li = ti - 832; }
        else if (ti < 1728) { src = p.w_in_odd; dst = (bf16_t*)(p.ws + OFF_WT1); K = 1024; N = 2560; tn = 40; li = ti - 1088; }
        else if (ti < 1984) { src = p.w_out_odd; dst = (bf16_t*)(p.ws + OFF_WO1T); K = 1024; N = 1024; tn = 16; li = ti - 1728; }
        else { const int si = ti - 1984, which = si >> 4, mat = (si >> 2) & 3; li = si & 3; K = 128; N = 128; tn = 2;
            if (which == 0) { src = p.w_pool + mat * 16384; dst = (bf16_t*)(p.ws + OFF_WPT) + mat * 16384; }
            else if (which == 1) { src = p.w_q + mat * 16384; dst = (bf16_t*)(p.ws + OFF_WQT) + mat * 16384; }
            else { src = p.w_k + mat * 16384; dst = (bf16_t*)(p.ws + OFF_WKT) + mat * 16384; scale = 0.08838834764831845f; } }
        const int k0 = (li / tn) * 64, n0 = (li % tn) * 64;
#pragma unroll
        for (int e = 0; e < 8; ++e) { const int idx = e * 512 + tid, kk = idx >> 6, nn = idx & 63, n = n0 + nn;
            t[kk * 65 + nn] = (n < N) ? src[(size_t)(k0 + kk) * N + n] * scale : 0.f; }
        __syncthreads();
#pragma unroll
        for (int e = 0; e < 8; ++e) { const int idx = e * 512 + tid, nn = idx >> 6, kk = idx & 63;
            dst[(size_t)(n0 + nn) * K + k0 + kk] = f2bf(t[kk * 65 + nn]); }
        __syncthreads();
    }
}

__device__ void phase_mix(const Params& p, unsigned char* smem) {
    int tid = threadIdx.x; asm volatile("" : "+v"(tid));
    const int wid = tid >> 6, lane = tid & 63, li = lane & 15, kq = lane >> 4;
    const bf16_t* P0 = (const bf16_t*)p.ws;
    bf16_t* CAT0 = (bf16_t*)p.out + (size_t)MTOK * 1024;
    bf16_t* Q0 = (bf16_t*)p.out; bf16_t* K0 = Q0 + (size_t)MTOK * 512;
    unsigned char* As = smem; unsigned char* Bs = smem + 32768; unsigned char* B2s = smem + 65536; unsigned char* halo = smem + 65536;
    const int g = blockIdx.x & 3;
    stage_tile(Bs, (const bf16_t*)(p.ws + OFF_WPT) + g * 16384, 128);
    const int tstep = gridDim.x >> 2, tlim = (REP_PH == 2 ? 1024 : 512);
#define TILE_DECODE(tile_) const int tile = (tile_) & 511; const int r0 = tile * 128; int T, ts0; \
        if (r0 < NPROMPT) { T = 4096; ts0 = r0 & 4095; } else { T = 2048; ts0 = (r0 - NPROMPT) & 2047; }
    {
        const int left = 1 << g, right = (1 << g) - 1;
        u32x4 hreg[5];
#define HLOAD(tile_) do { TILE_DECODE(tile_); const int seqbase = r0 - ts0; \
        _Pragma("unroll") for (int i = 0; i < 5; ++i) { const int idx = tid + 512 * i, row = idx >> 4, ch = idx & 15, tt = ts0 - 8 + row; \
            hreg[i] = (u32x4){0u, 0u, 0u, 0u}; \
            if (idx < 2304 && tt >= 0 && tt < T) hreg[i] = *(const u32x4*)(P0 + (size_t)(seqbase + tt) * LDP + g * 128 + ch * 8); } } while (0)
        HLOAD(blockIdx.x >> 2);
        for (int tile_ = blockIdx.x >> 2; tile_ < tlim; tile_ += tstep) {
            TILE_DECODE(tile_);
#pragma unroll
            for (int i = 0; i < 5; ++i) { const int idx = tid + 512 * i; if (idx < 2304) *(u32x4*)(halo + (idx >> 4) * 256 + (idx & 15) * 16) = hreg[i]; }
            const size_t r = (size_t)r0 + wid * 16 + li;
            u32x2 zreg[8];
#pragma unroll
            for (int nb = 0; nb < 8; ++nb) zreg[nb] = *(const u32x2*)(P0 + r * LDP + 512 + g * 128 + nb * 16 + kq * 4);
            __syncthreads();
            { const int c2 = tid & 63, tq = tid >> 6;
              float s0 = 0.f, s1 = 0.f; const int tl0 = tq * 16;
              for (int j = tl0 - left; j <= tl0 + right; ++j) { const unsigned w = *(const unsigned*)(halo + (j + 8) * 256 + c2 * 4); s0 += bflo(w); s1 += bfhi(w); }
              for (int tl = tl0; tl < tl0 + 16; ++tl) { const int t = ts0 + tl; const int lo = max(t - left, 0), hi = min(t + right + 1, T);
                  const float inv = __builtin_amdgcn_rcpf((float)(hi - lo)); const unsigned xw = *(const unsigned*)(halo + (tl + 8) * 256 + c2 * 4);
                  *(unsigned*)(As + swz(tl, c2 >> 2) + (c2 & 3) * 4) = cvt_pk(s0 * inv - bflo(xw), s1 * inv - bfhi(xw));
                  const unsigned wn = *(const unsigned*)(halo + (tl + 1 + right + 8) * 256 + c2 * 4), wo = *(const unsigned*)(halo + (tl - left + 8) * 256 + c2 * 4);
                  s0 += bflo(wn) - bflo(wo); s1 += bfhi(wn) - bfhi(wo); } }
            __syncthreads();
            HLOAD((tile_ + tstep < tlim) ? tile_ + tstep : tile_);
            bf16x8 af[4]; ldfrag(af, As, wid, lane);
            f32x4 acc[8];
#pragma unroll
            for (int nb = 0; nb < 8; ++nb) acc[nb] = (f32x4){0.f, 0.f, 0.f, 0.f};
            mm16<8>(acc, Bs, af, lane);
#pragma unroll
            for (int nb = 0; nb < 8; ++nb) { const int d = nb * 16 + kq * 4;
                const u32x2 za = zreg[nb]; const f32x4 ps = *(const f32x4*)(p.pool_scale + g * 128 + d);
                u32x2 o; o.x = cvt_pk(acc[nb][0] * ps[0] * silu(bflo(za.x)), acc[nb][1] * ps[1] * silu(bfhi(za.x)));
                o.y = cvt_pk(acc[nb][2] * ps[2] * silu(bflo(za.y)), acc[nb][3] * ps[3] * silu(bfhi(za.y)));
                *(u32x2*)(CAT0 + r * 1024 + g * 128 + d) = o; }
        }
#undef HLOAD
    }
    __syncthreads();
    {
        const int h = g;
        stage_tile(Bs, (const bf16_t*)(p.ws + OFF_WQT) + h * 16384, 128);
        stage_tile(B2s, (const bf16_t*)(p.ws + OFF_WKT) + h * 16384, 128);
        const int ch = tid & 15, cc = h * 128 + ch * 8;
        float cw[3][8], cb[8];
#pragma unroll
        for (int e = 0; e < 8; ++e) { cb[e] = p.conv_b[cc + e];
#pragma unroll
            for (int j = 0; j < 3; ++j) cw[j][e] = p.conv_w[j * 512 + cc + e]; }
        u32x4 creg[4][3];
#define CLOAD(tile_) do { TILE_DECODE(tile_); \
        _Pragma("unroll") for (int i = 0; i < 4; ++i) { const int tl = (tid >> 4) + 32 * i, t = ts0 + tl; const long r = (long)r0 + tl; \
            _Pragma("unroll") for (int j = 0; j < 3; ++j) { const int tt = t - 1 + j; creg[i][j] = (u32x4){0u, 0u, 0u, 0u}; \
                if (tt >= 0 && tt < T) creg[i][j] = *(const u32x4*)(P0 + (size_t)(r - 1 + j) * LDP + 1024 + cc); } } } while (0)
        CLOAD(blockIdx.x >> 2);
        for (int tile_ = blockIdx.x >> 2; tile_ < tlim; tile_ += tstep) {
            TILE_DECODE(tile_); (void)T; (void)ts0;
#pragma unroll
            for (int i = 0; i < 4; ++i) { const int tl = (tid >> 4) + 32 * i; const size_t r = (size_t)r0 + tl;
                float a[8];
#pragma unroll
                for (int e = 0; e < 8; ++e) a[e] = cb[e];
#pragma unroll
                for (int j = 0; j < 3; ++j) { const u32x4 v = creg[i][j];
                    a[0] += bflo(v.x) * cw[j][0]; a[1] += bfhi(v.x) * cw[j][1]; a[2] += bflo(v.y) * cw[j][2]; a[3] += bfhi(v.y) * cw[j][3];
                    a[4] += bflo(v.z) * cw[j][4]; a[5] += bfhi(v.z) * cw[j][5]; a[6] += bflo(v.w) * cw[j][6]; a[7] += bfhi(v.w) * cw[j][7]; }
                u32x4 w; w.x = cvt_pk(silu(a[0]), silu(a[1])); w.y = cvt_pk(silu(a[2]), silu(a[3])); w.z = cvt_pk(silu(a[4]), silu(a[5])); w.w = cvt_pk(silu(a[6]), silu(a[7]));
                *(u32x4*)(As + swz(tl, ch)) = w; *(u32x4*)(CAT0 + r * 1024 + 512 + cc) = w; }
            __syncthreads();
            CLOAD((tile_ + tstep < tlim) ? tile_ + tstep : tile_);
            bf16x8 af[4]; ldfrag(af, As, wid, lane);
            const size_t r = (size_t)r0 + wid * 16 + li;
#pragma unroll
            for (int which = 0; which < 2; ++which) {
                f32x4 acc[8];
#pragma unroll
                for (int nb = 0; nb < 8; ++nb) acc[nb] = (f32x4){0.f, 0.f, 0.f, 0.f};
                mm16<8>(acc, which ? B2s : Bs, af, lane);
                bf16_t* O = which ? K0 : Q0;
#pragma unroll
                for (int nb = 0; nb < 8; ++nb) { u32x2 o; o.x = cvt_pk(acc[nb][0], acc[nb][1]); o.y = cvt_pk(acc[nb][2], acc[nb][3]);
                    *(u32x2*)(O + r * 512 + h * 128 + nb * 16 + kq * 4) = o; }
            }
            __syncthreads();
        }
#undef CLOAD
    }
#undef TILE_DECODE
}

template <int SPLIT> __device__ __forceinline__ void scan_item(const Params& p, unsigned char* smem, const int item, const int vh) {
    constexpr int NBV = SPLIT ? 4 : 8;
    int tid = threadIdx.x; asm volatile("" : "+v"(tid));
    const int wid = tid >> 6, lane = tid & 63, li = lane & 15, kq = lane >> 4;
    bf16_t* P0 = (bf16_t*)p.ws;
    const bf16_t* Q0 = (const bf16_t*)p.out; const bf16_t* K0 = Q0 + (size_t)MTOK * 512;
    const float* GATES = (const float*)(p.ws + OFF_GATES);
    unsigned char* KP = smem; unsigned char* VT = smem + 32768; unsigned char* KT = smem + 65536; unsigned char* CS = smem + 98304;
    float* g_s = (float*)(smem + 131072); float* a_s = g_s + 128; float* M_s = a_s + 128; float* n_s = M_s + 128; float* sc = n_s + 128;
    {
        int b, h, dir, T, rb;
        if (item < 64) { b = item >> 3; h = (item >> 1) & 3; dir = item & 1; T = 4096; rb = b * 4096; }
        else { const int it = item - 64; b = it >> 3; h = (it >> 1) & 3; dir = it & 1; T = 2048; rb = NPROMPT + b * 2048; }
        const int nc = T >> 7;
        const int rfirst = dir ? rb + T - 1 : rb, rstep = dir ? -1 : 1;
        const float bgi = p.bgi[dir * 4 + h], bgf = p.bgf[dir * 4 + h];
        for (int idx = tid; idx < 2048; idx += 512) *(u32x4*)(CS + idx * 16) = (u32x4){0u, 0u, 0u, 0u};
        if (tid < 128) n_s[tid] = 0.f;
        float m_run = -1e30f;
        f32x4 Cacc[NBV];
#pragma unroll
        for (int nb = 0; nb < NBV; ++nb) Cacc[nb] = (f32x4){0.f, 0.f, 0.f, 0.f};
        const int vblk = SPLIT ? 4 * vh + (wid & 3) : wid, kh = SPLIT ? (wid >> 2) : 0;
        const int sp = tid & 31, ch = tid >> 5;
        u32x4 kreg[4], vreg[4]; bf16x8 qf[4];
#define SCAN_LOAD(j) do { \
        _Pragma("unroll") for (int i = 0; i < 4; ++i) { const size_t r = (size_t)(rfirst + rstep * ((j) * 128 + sp * 4 + i)); \
            kreg[i] = *(const u32x4*)(K0 + r * 512 + h * 128 + ch * 8); vreg[i] = *(const u32x4*)(P0 + r * LDP + 1536 + h * 128 + ch * 8); } \
        } while (0)
#define Q_LOAD(j) do { const size_t r = (size_t)(rfirst + rstep * ((j) * 128 + wid * 16 + li)); \
          _Pragma("unroll") for (int ks = 0; ks < 4; ++ks) qf[ks] = *(const bf16x8*)(Q0 + r * 512 + h * 128 + ks * 32 + kq * 8); } while (0)
#define GATE_LOAD(j) do { pg = *(const float2*)(scr + (j) * 384 + 2 * lane); pa = *(const float2*)(scr + (j) * 384 + 128 + 2 * lane); \
        ppm = *(const float2*)(scr + (j) * 384 + 256 + 2 * lane); pG = scr[32 * 384 + (j)]; pPM = scr[32 * 384 + 32 + (j)]; } while (0)
        float* scr = (float*)(p.ws + OFF_SCR) + (size_t)item * SCR_ITEM;
        for (int j = wid; j < nc; j += 8) {
            const size_t ra = (size_t)(rfirst + rstep * (j * 128 + 2 * lane)), rc = (size_t)(rfirst + rstep * (j * 128 + 2 * lane + 1));
            const float ig0 = GATES[ra * 16 + dir * 4 + h] + bgi, ig1 = GATES[rc * 16 + dir * 4 + h] + bgi;
            const float x0 = GATES[ra * 16 + 8 + dir * 4 + h] + bgf, x1 = GATES[rc * 16 + 8 + dir * 4 + h] + bgf;
            const float lf0 = fminf(x0, 0.f) - log1pf(expf(-fabsf(x0))), lf1 = fminf(x1, 0.f) - log1pf(expf(-fabsf(x1)));
            float ps = lf0 + lf1;
#pragma unroll
            for (int off = 1; off < 64; off <<= 1) { const float v = __shfl_up(ps, off); if (lane >= off) ps += v; }
            float ex = __shfl_up(ps, 1); if (lane == 0) ex = 0.f;
            const float g0 = ex + lf0, g1 = g0 + lf1;
            const float a0 = ig0 - g0, a1 = ig1 - g1;
            float pm = fmaxf(a0, a1);
#pragma unroll
            for (int off = 1; off < 64; off <<= 1) { const float v = __shfl_up(pm, off); if (lane >= off) pm = fmaxf(pm, v); }
            float pe = __shfl_up(pm, 1); if (lane == 0) pe = -3.0e38f;
            const float pm0 = fmaxf(pe, a0), pm1 = fmaxf(pm0, a1);
            float* cj = scr + j * 384;
            *(float2*)(cj + 2 * lane) = make_float2(g0, g1); *(float2*)(cj + 128 + 2 * lane) = make_float2(a0, a1); *(float2*)(cj + 256 + 2 * lane) = make_float2(pm0, pm1);
            if (lane == 63) { scr[32 * 384 + j] = g1; scr[32 * 384 + 32 + j] = pm1; }
        }
        __builtin_amdgcn_fence(__ATOMIC_SEQ_CST, "workgroup"); __syncthreads();
        float2 pg = make_float2(0.f, 0.f), pa = pg, ppm = pg; float pG = 0.f, pPM = 0.f;
        SCAN_LOAD(0); Q_LOAD(0);
        if (wid == 0) GATE_LOAD(0);
        for (int j = 0; j < nc; ++j) {
            const int jn = (j + 1 < nc) ? j + 1 : j;
            if (wid == 0) {
                const float M127 = fmaxf(m_run, pPM);
                g_s[2 * lane] = pg.x; g_s[2 * lane + 1] = pg.y; a_s[2 * lane] = pa.x; a_s[2 * lane + 1] = pa.y;
                M_s[2 * lane] = fmaxf(m_run, ppm.x); M_s[2 * lane + 1] = fmaxf(m_run, ppm.y);
                if (lane == 0) { sc[0] = m_run; sc[1] = M127; }
                m_run = pG + M127;
                GATE_LOAD(jn);
            }
            __syncthreads();
            const float m_old = sc[0], M127 = sc[1];
            const float decay = __expf(m_old - M127);
            {
                const f32x4 a4 = *(const f32x4*)(a_s + sp * 4);
                float wsv[4];
#pragma unroll
                for (int i = 0; i < 4; ++i) wsv[i] = __expf(a4[i] - M127);
#pragma unroll
                for (int i = 0; i < 4; ++i) { const u32x4 k = kreg[i]; u32x4 w;
                    w.x = cvt_pk(bflo(k.x) * wsv[i], bfhi(k.x) * wsv[i]); w.y = cvt_pk(bflo(k.y) * wsv[i], bfhi(k.y) * wsv[i]);
                    w.z = cvt_pk(bflo(k.z) * wsv[i], bfhi(k.z) * wsv[i]); w.w = cvt_pk(bflo(k.w) * wsv[i], bfhi(k.w) * wsv[i]);
                    *(u32x4*)(KP + swz(sp * 4 + i, ch)) = w; }
#pragma unroll
                for (int e2 = 0; e2 < 4; ++e2) {
                    const unsigned k0 = kreg[0][e2], k1 = kreg[1][e2], k2 = kreg[2][e2], k3 = kreg[3][e2];
                    const unsigned v0 = vreg[0][e2], v1 = vreg[1][e2], v2 = vreg[2][e2], v3 = vreg[3][e2];
                    const int d0 = ch * 8 + 2 * e2, d1 = d0 + 1; const int co = (sp & 1) * 8;
                    u32x2 o;
                    o.x = cvt_pk(bflo(k0) * wsv[0], bflo(k1) * wsv[1]); o.y = cvt_pk(bflo(k2) * wsv[2], bflo(k3) * wsv[3]);
                    *(u32x2*)(KT + swz(d0, sp >> 1) + co) = o;
                    o.x = cvt_pk(bfhi(k0) * wsv[0], bfhi(k1) * wsv[1]); o.y = cvt_pk(bfhi(k2) * wsv[2], bfhi(k3) * wsv[3]);
                    *(u32x2*)(KT + swz(d1, sp >> 1) + co) = o;
                    o.x = (v0 & 0xffffu) | (v1 << 16); o.y = (v2 & 0xffffu) | (v3 << 16);
                    *(u32x2*)(VT + swz(d0, sp >> 1) + co) = o;
                    o.x = (v0 >> 16) | (v1 & 0xffff0000u); o.y = (v2 >> 16) | (v3 & 0xffff0000u);
                    *(u32x2*)(VT + swz(d1, sp >> 1) + co) = o;
                }
            }
            const size_t rowl = (size_t)(rfirst + rstep * (j * 128 + wid * 16 + li));
            __syncthreads();
            SCAN_LOAD(jn);
            __builtin_amdgcn_sched_barrier(0);
            const int l = wid * 16 + li;
            const float Ml = M_s[l], gl = g_s[l];
            f32x4 acc[8];
#pragma unroll
            for (int nb = 0; nb < 8; ++nb) acc[nb] = (f32x4){0.f, 0.f, 0.f, 0.f};
            mm16<8>(acc, KP, qf, lane);
            __builtin_amdgcn_sched_barrier(0);
            float rs = 0.f; u32x2 pp[8];
            const float rowf = __expf(fminf(sc[1] - Ml, 80.f));
            const int widu = __builtin_amdgcn_readfirstlane(wid);
#pragma unroll
            for (int nb = 0; nb < 8; ++nb) {
                if (nb < widu) { const f32x4 pv = acc[nb]; rs += (pv[0] + pv[1]) + (pv[2] + pv[3]); pp[nb].x = cvt_pk(pv[0], pv[1]); pp[nb].y = cvt_pk(pv[2], pv[3]); }
                else if (nb == widu) { float pv[4];
#pragma unroll
                    for (int jj = 0; jj < 4; ++jj) { const int s = nb * 16 + kq * 4 + jj; pv[jj] = (s <= l) ? acc[nb][jj] : 0.f; rs += pv[jj]; }
                    pp[nb].x = cvt_pk(pv[0], pv[1]); pp[nb].y = cvt_pk(pv[2], pv[3]); }
                else { pp[nb].x = 0u; pp[nb].y = 0u; } }
            __builtin_amdgcn_sched_barrier(0);
            float nq = 0.f;
#pragma unroll
            for (int ks = 0; ks < 4; ++ks) { const f32x4 n0 = *(const f32x4*)(n_s + ks * 32 + kq * 8), n1 = *(const f32x4*)(n_s + ks * 32 + kq * 8 + 4);
                const u32x4 qw = *(const u32x4*)&qf[ks];
                nq += bflo(qw.x) * n0[0] + bfhi(qw.x) * n0[1] + bflo(qw.y) * n0[2] + bfhi(qw.y) * n0[3] + bflo(qw.z) * n1[0] + bfhi(qw.z) * n1[1] + bflo(qw.w) * n1[2] + bfhi(qw.w) * n1[3]; }
            rs += __shfl_xor(rs, 16); rs += __shfl_xor(rs, 32); nq += __shfl_xor(nq, 16); nq += __shfl_xor(nq, 32);
            const float exl = __expf(m_old - Ml);
            const float den = rowf * rs + exl * nq;
            const float hinv = rowf * __builtin_amdgcn_rcpf(fmaxf(fabsf(den), __expf(-(gl + Ml))));
            __syncthreads();
#pragma unroll
            for (int nb = 0; nb < 8; ++nb) *(u32x2*)(KP + swz(l, nb * 2 + (kq >> 1)) + (kq & 1) * 8) = pp[nb];
            f32x4 acc2[NBV];
#pragma unroll
            for (int nb = 0; nb < NBV; ++nb) acc2[nb] = (f32x4){0.f, 0.f, 0.f, 0.f};
            __builtin_amdgcn_sched_barrier(0);
            mm16<NBV>(acc2, CS + vh * 16384, qf, lane);
            __builtin_amdgcn_sched_barrier(0);
            Q_LOAD(jn);
#pragma unroll
            for (int nb = 0; nb < NBV; ++nb) acc2[nb] *= decay;
            __builtin_amdgcn_sched_barrier(0);
            { bf16x8 pf[4]; ldfrag(pf, KP, wid, lane); mm16<NBV>(acc2, VT + vh * 16384, pf, lane); }
            __builtin_amdgcn_sched_barrier(0);
            { bf16_t* hp = P0 + rowl * LDP + dir * 512 + h * 128 + vh * 64 + kq * 4;
#pragma unroll
              for (int nb = 0; nb < NBV; ++nb) { u32x2 o; o.x = cvt_pk(acc2[nb][0] * hinv, acc2[nb][1] * hinv); o.y = cvt_pk(acc2[nb][2] * hinv, acc2[nb][3] * hinv);
                  *(u32x2*)(hp + nb * 16) = o; } }
            __builtin_amdgcn_sched_barrier(0);
            float nnew;
            { bf16x8 vf[4]; ldfrag(vf, VT, vblk, lane);
#pragma unroll
              for (int nb = 0; nb < NBV; ++nb) Cacc[nb] *= decay;
              mm16<NBV>(Cacc, KT + kh * 16384, vf, lane);
              float part = 0.f;
#pragma unroll
              for (int ks = 0; ks < 4; ++ks) { const u32x4 kw = *(const u32x4*)(KT + swz(wid * 16 + li, ks * 4 + kq));
                  part += bflo(kw.x) + bfhi(kw.x) + bflo(kw.y) + bfhi(kw.y) + bflo(kw.z) + bfhi(kw.z) + bflo(kw.w) + bfhi(kw.w); }
              part += __shfl_xor(part, 16); part += __shfl_xor(part, 32);
              nnew = decay * n_s[wid * 16 + li] + part; }
            __syncthreads();
#pragma unroll
            for (int nb = 0; nb < NBV; ++nb) { u32x2 o; o.x = cvt_pk(Cacc[nb][0], Cacc[nb][1]); o.y = cvt_pk(Cacc[nb][2], Cacc[nb][3]);
                *(u32x2*)(CS + swz(vblk * 16 + li, (kh * 4 + nb) * 2 + (kq >> 1)) + (kq & 1) * 8) = o; }
            if (kq == 0) n_s[wid * 16 + li] = nnew;
        }
        __syncthreads();
#undef SCAN_LOAD
#undef Q_LOAD
#undef GATE_LOAD
    }
}
__device__ void phase_scan(const Params& p, unsigned char* smem) {
    for (int rep_ = 0; rep_ < (REP_PH == 3 ? 2 : 1); ++rep_) {
        const int c = blockIdx.x;
        if (c < 128) scan_item<1>(p, smem, c >> 1, c & 1); else scan_item<0>(p, smem, 64 + (c - 128), 0);
    }
}

__device__ void panel_outb(const Params& p, int r0) {
    const int wid = threadIdx.x >> 6, lane = threadIdx.x & 63, col = (lane >> 4) * 128 + (lane & 15) * 8;
    const bf16_t* P0 = (const bf16_t*)p.ws; bf16_t* CAT0 = (bf16_t*)p.out + (size_t)MTOK * 1024;
    float gg[8], sk[8];
#pragma unroll
    for (int e = 0; e < 8; ++e) { gg[e] = p.mh_g[col + e]; sk[e] = p.skip[col + e]; }
    u32x4 pre[5];
#define OB_LOAD(it) do { const size_t r_ = (size_t)r0 + (it) * 8 + wid; const bf16_t* pr_ = P0 + r_ * LDP; \
        pre[0] = *(const u32x4*)(pr_ + col); pre[1] = *(const u32x4*)(pr_ + 512 + col); pre[2] = *(const u32x4*)(pr_ + 2048 + col); pre[3] = *(const u32x4*)(pr_ + 2560 + col); \
        pre[4] = *(const u32x4*)(CAT0 + r_ * 1024 + 512 + col); } while (0)
    OB_LOAD(0);
    for (int it = 0; it < 32; ++it) {
        const size_t r = (size_t)r0 + it * 8 + wid;
        const u32x4 hf = pre[0], hb = pre[1], ob = pre[2], zb = pre[3], xc = pre[4];
        OB_LOAD((it + 1 < 32) ? it + 1 : it);
        float hv[8], o[8], z[8], x[8];
#pragma unroll
        for (int w = 0; w < 4; ++w) { hv[2 * w] = bflo(hf[w]) + bflo(hb[w]); hv[2 * w + 1] = bfhi(hf[w]) + bfhi(hb[w]); o[2 * w] = bflo(ob[w]); o[2 * w + 1] = bfhi(ob[w]);
            z[2 * w] = bflo(zb[w]); z[2 * w + 1] = bfhi(zb[w]); x[2 * w] = bflo(xc[w]); x[2 * w + 1] = bfhi(xc[w]); }
        float s = 0.f;
#pragma unroll
        for (int e = 0; e < 8; ++e) { hv[e] *= sigm(o[e]); s += hv[e]; }
        s += __shfl_xor(s, 1); s += __shfl_xor(s, 2); s += __shfl_xor(s, 4); s += __shfl_xor(s, 8);
        const float mu = s * (1.f / 128.f); float v = 0.f;
#pragma unroll
        for (int e = 0; e < 8; ++e) { hv[e] -= mu; v += hv[e] * hv[e]; }
        v += __shfl_xor(v, 1); v += __shfl_xor(v, 2); v += __shfl_xor(v, 4); v += __shfl_xor(v, 8);
        const float rstd = rsqrtf(v * (1.f / 128.f) + 1e-5f);
        float ov[8];
#pragma unroll
        for (int e = 0; e < 8; ++e) ov[e] = (hv[e] * rstd * gg[e] + sk[e] * x[e]) * silu(z[e]);
        u32x4 w; w.x = cvt_pk(ov[0], ov[1]); w.y = cvt_pk(ov[2], ov[3]); w.z = cvt_pk(ov[4], ov[5]); w.w = cvt_pk(ov[6], ov[7]);
        *(u32x4*)(CAT0 + r * 1024 + 512 + col) = w;
    }
#undef OB_LOAD
}
template <int OUT_F32> __device__ void panel_ln(const bf16_t* Y, const float* xp, const float* xs, const float* g, const float* b, void* dst, int r0) {
    const int wid = threadIdx.x >> 6, lane = threadIdx.x & 63;
    u32x4 wy[2]; f32x4 wx[2][2];
#define LN_LOAD(it) do { const size_t r_ = (size_t)r0 + (it) * 8 + wid; const bf16_t* y_ = Y + r_ * LDP; \
        _Pragma("unroll") for (int i = 0; i < 2; ++i) { const int c_ = i * 512 + lane * 8; wy[i] = *(const u32x4*)(y_ + c_); \
            if (!OUT_F32) { const float* src_ = (r_ < NPROMPT ? xp + r_ * 1024 : xs + (r_ - NPROMPT) * 1024) + c_; wx[i][0] = __builtin_nontemporal_load((const f32x4*)src_); wx[i][1] = __builtin_nontemporal_load((const f32x4*)(src_ + 4)); } } } while (0)
    LN_LOAD(0);
    for (int it = 0; it < 32; ++it) {
        const size_t r = (size_t)r0 + it * 8 + wid;
        float v[2][8]; float s = 0.f;
#pragma unroll
        for (int i = 0; i < 2; ++i) { const u32x4 w = wy[i];
            v[i][0] = bflo(w.x); v[i][1] = bfhi(w.x); v[i][2] = bflo(w.y); v[i][3] = bfhi(w.y); v[i][4] = bflo(w.z); v[i][5] = bfhi(w.z); v[i][6] = bflo(w.w); v[i][7] = bfhi(w.w);
            if (!OUT_F32) {
#pragma unroll
                for (int e = 0; e < 4; ++e) { v[i][e] += wx[i][0][e] * ALPHA; v[i][4 + e] += wx[i][1][e] * ALPHA; } }
#pragma unroll
            for (int e = 0; e < 8; ++e) s += v[i][e]; }
        LN_LOAD((it + 1 < 32) ? it + 1 : it);
#pragma unroll
        for (int off = 1; off < 64; off <<= 1) s += __shfl_xor(s, off);
        const float mu = s * (1.f / 1024.f); float q = 0.f;
#pragma unroll
        for (int i = 0; i < 2; ++i)
#pragma unroll
            for (int e = 0; e < 8; ++e) { v[i][e] -= mu; q += v[i][e] * v[i][e]; }
#pragma unroll
        for (int off = 1; off < 64; off <<= 1) q += __shfl_xor(q, off);
        const float rstd = rsqrtf(q * (1.f / 1024.f) + 1e-5f);
#pragma unroll
        for (int i = 0; i < 2; ++i) { const int c = i * 512 + lane * 8; const f32x4 g0 = *(const f32x4*)(g + c), g1 = *(const f32x4*)(g + c + 4), b0 = *(const f32x4*)(b + c), b1 = *(const f32x4*)(b + c + 4);
            f32x4 o0, o1;
#pragma unroll
            for (int e = 0; e < 4; ++e) { o0[e] = v[i][e] * rstd * g0[e] + b0[e]; o1[e] = v[i][4 + e] * rstd * g1[e] + b1[e]; }
            if (OUT_F32) { __builtin_nontemporal_store(o0, (f32x4*)((float*)dst + r * 1024 + c)); __builtin_nontemporal_store(o1, (f32x4*)((float*)dst + r * 1024 + c + 4)); }
            else { u32x4 w; w.x = cvt_pk(o0[0], o0[1]); w.y = cvt_pk(o0[2], o0[3]); w.z = cvt_pk(o1[0], o1[1]); w.w = cvt_pk(o1[2], o1[3]); *(u32x4*)((bf16_t*)dst + r * 1024 + c) = w; } }
    }
#undef LN_LOAD
}
__device__ void panel_qknorm(const Params& p, int r0) {
    const int wid = threadIdx.x >> 6, lane = threadIdx.x & 63, sub = lane >> 4, l16 = lane & 15;
    bf16_t* P1 = (bf16_t*)p.ws;
    const int axis = l16 >> 3, f0 = (l16 & 7) * 4, d1 = axis * 64 + f0, d2 = d1 + 32;
    float inv[4];
#pragma unroll
    for (int e = 0; e < 4; ++e) inv[e] = exp2f(-(float)(f0 + e) * (13.287712379549449f / 32.f));
    for (int u = wid * 4 + sub; u < 512; u += 32) {
        const int rl = u >> 1, hh = 8 + (u & 1); const size_t r = (size_t)r0 + rl;
        const int t = (r < NPROMPT) ? (int)(r & 4095) : (int)((r - NPROMPT) & 2047);
        const float pos = (float)(axis ? (t & 63) : (t >> 6));
        bf16_t* base = P1 + r * LDP + (hh < 8 ? hh * 128 : 1024 + (hh - 8) * 128);
        const float* gn = hh < 8 ? p.qng : p.kng;
        const u32x2 w1 = *(const u32x2*)(base + d1), w2 = *(const u32x2*)(base + d2);
        float x1[4] = {bflo(w1.x), bfhi(w1.x), bflo(w1.y), bfhi(w1.y)}, x2[4] = {bflo(w2.x), bfhi(w2.x), bflo(w2.y), bfhi(w2.y)};
        float ss = 0.f;
#pragma unroll
        for (int e = 0; e < 4; ++e) ss += x1[e] * x1[e] + x2[e] * x2[e];
        ss += __shfl_xor(ss, 1); ss += __shfl_xor(ss, 2); ss += __shfl_xor(ss, 4); ss += __shfl_xor(ss, 8);
        const float rinv = rsqrtf(ss * (1.f / 128.f) + 1e-6f);
        const f32x4 g1 = *(const f32x4*)(gn + d1), g2 = *(const f32x4*)(gn + d2);
        float o1[4], o2[4];
#pragma unroll
        for (int e = 0; e < 4; ++e) { const float a = x1[e] * rinv * g1[e], bb = x2[e] * rinv * g2[e];
            const float ang = pos * inv[e]; float sn, cs; __sincosf(ang, &sn, &cs);
            o1[e] = a * cs - bb * sn; o2[e] = bb * cs + a * sn; }
        u32x2 q1, q2; q1.x = cvt_pk(o1[0], o1[1]); q1.y = cvt_pk(o1[2], o1[3]); q2.x = cvt_pk(o2[0], o2[1]); q2.y = cvt_pk(o2[2], o2[3]);
        *(u32x2*)(base + d1) = q1; *(u32x2*)(base + d2) = q2;
    }
}

namespace att {
constexpr int D = 128, NW = 8, QBLK = 32, KVBLK = 64;
constexpr float SCALE = 0.088388347648318440f, THR = 8.f;
constexpr size_t SHM_V = KVBLK * D * 2, SHM_K = KVBLK * D * 2;
#define KSWZ(row, colB) ((row) * 256 + ((colB) ^ (((row) & 15) << 4)))
#define SBAR() __builtin_amdgcn_sched_barrier(0)
__device__ __forceinline__ int crow(int r, int hi) { return (r & 3) + 8 * (r >> 2) + 4 * hi; }
__device__ __forceinline__ void partialSM(f32x16& p0, f32x16& p1, float shift) {
    if (shift != 0.f) { for (int r = 0; r < 16; ++r) { p0[r] += shift; p1[r] += shift; } }
    for (int r = 0; r < 16; ++r) p0[r] = __builtin_amdgcn_exp2f(p0[r]);
}
__device__ __forceinline__ void finishSM(f32x16& p0, f32x16& p1, float alpha, float& l_reg, bf16x8& pa0, bf16x8& pa1, bf16x8& pa2, bf16x8& pa3) {
    for (int r = 0; r < 16; ++r) p1[r] = __builtin_amdgcn_exp2f(p1[r]);
    float ps = 0; for (int r = 0; r < 16; ++r) ps += p0[r]; for (int r = 0; r < 16; ++r) ps += p1[r];
    { auto rr = __builtin_amdgcn_permlane32_swap(__float_as_uint(ps), __float_as_uint(ps), false, false);
      ps = __uint_as_float(rr[0]) + __uint_as_float(rr[1]); }
    l_reg = l_reg * alpha + ps;
#define PK4(P, BASE, OUT) do { unsigned a0 = cvt_pk(P[BASE + 0], P[BASE + 1]), a1 = cvt_pk(P[BASE + 2], P[BASE + 3]);   \
    unsigned b0 = cvt_pk(P[BASE + 4], P[BASE + 5]), b1 = cvt_pk(P[BASE + 6], P[BASE + 7]);                              \
    auto r0 = __builtin_amdgcn_permlane32_swap(a0, b0, false, false); auto r1 = __builtin_amdgcn_permlane32_swap(a1, b1, false, false); \
    u32x4 w = {r0[0], r1[0], r0[1], r1[1]}; OUT = *reinterpret_cast<bf16x8*>(&w); } while (0)
    PK4(p0, 0, pa0); PK4(p0, 8, pa1); PK4(p1, 0, pa2); PK4(p1, 8, pa3);
#undef PK4
}
__device__ __forceinline__ void qkt(f32x16& p0, f32x16& p1, const bf16_t* Ks, const bf16x8* qr, int r32, int hi) {
    p0 = f32x16{}; p1 = f32x16{};
    for (int d0 = 0; d0 < 8; ++d0) { int cb = (d0 * 16 + hi * 8) * 2;
        bf16x8 b0 = *reinterpret_cast<const bf16x8*>((const char*)Ks + KSWZ(r32, cb));
        bf16x8 b1 = *reinterpret_cast<const bf16x8*>((const char*)Ks + KSWZ(32 + r32, cb));
        p0 = __builtin_amdgcn_mfma_f32_32x32x16_bf16(b0, qr[d0], p0, 0, 0, 0);
        p1 = __builtin_amdgcn_mfma_f32_32x32x16_bf16(b1, qr[d0], p1, 0, 0, 0); }
}
__device__ __forceinline__ int v_st(int k, int c) { const int kk = (k & ~0xC) | ((k & 4) << 1) | ((k & 8) >> 1); return ((kk >> 3) * 4 + (c >> 5)) * 512 + ((kk & 7) * 32 + (c & 31)) * 2; }
__device__ __forceinline__ int v_rd_base(int lane) { return ((lane & 3) << 3) | (((lane >> 2) & 3) << 6) | (((lane >> 4) & 1) << 5) | (((lane >> 5) & 1) << 8); }
constexpr int v_rd_off(int d0, int ks, int half) { return d0 * 512 + ks * 4096 + half * 2048; }
template <int OFF> __device__ __forceinline__ s16x4 tr_read(int vb) {
    s16x4 r; asm volatile("ds_read_b64_tr_b16 %0, %1 offset:%2" : "=&v"(r) : "v"(vb), "i"(OFF) : "memory"); return r;
}
template <int D0> __device__ __forceinline__ void pv_one(f32x16& od, int vb, bf16x8 pa0, bf16x8 pa1, bf16x8 pa2, bf16x8 pa3) {
    const s16x4 l0 = tr_read<v_rd_off(D0, 0, 0)>(vb), h0 = tr_read<v_rd_off(D0, 0, 1)>(vb), l1 = tr_read<v_rd_off(D0, 1, 0)>(vb), h1 = tr_read<v_rd_off(D0, 1, 1)>(vb);
    const s16x4 l2 = tr_read<v_rd_off(D0, 2, 0)>(vb), h2 = tr_read<v_rd_off(D0, 2, 1)>(vb), l3 = tr_read<v_rd_off(D0, 3, 0)>(vb), h3 = tr_read<v_rd_off(D0, 3, 1)>(vb);
    asm volatile("s_waitcnt lgkmcnt(0)" ::: "memory"); SBAR();
#define PK(L, H) (bf16x8){L[0], L[1], L[2], L[3], H[0], H[1], H[2], H[3]}
    od = __builtin_amdgcn_mfma_f32_32x32x16_bf16(pa0, PK(l0, h0), od, 0, 0, 0);
    od = __builtin_amdgcn_mfma_f32_32x32x16_bf16(pa1, PK(l1, h1), od, 0, 0, 0);
    od = __builtin_amdgcn_mfma_f32_32x32x16_bf16(pa2, PK(l2, h2), od, 0, 0, 0);
    od = __builtin_amdgcn_mfma_f32_32x32x16_bf16(pa3, PK(l3, h3), od, 0, 0, 0);
#undef PK
}
__device__ __forceinline__ void pv_d0(f32x16* o, int vb, bf16x8 pa0, bf16x8 pa1, bf16x8 pa2, bf16x8 pa3) {
    pv_one<0>(o[0], vb, pa0, pa1, pa2, pa3); pv_one<1>(o[1], vb, pa0, pa1, pa2, pa3); pv_one<2>(o[2], vb, pa0, pa1, pa2, pa3); pv_one<3>(o[3], vb, pa0, pa1, pa2, pa3);
}
__device__ __forceinline__ void attn_body(const bf16_t* __restrict__ Qb, const bf16_t* __restrict__ Kh, const bf16_t* __restrict__ Vh, const bf16_t* __restrict__ Zb,
                                          bf16_t* __restrict__ Ob, int seq, char* lds, int tq0, const float* __restrict__ qg, const float* __restrict__ rope, float negBC) {
    constexpr int LDQ = LDP, LDK = LDP;
    int tid = threadIdx.x; asm volatile("" : "+v"(tid));
    const int wid = tid >> 6, lane = tid & 63, r32 = lane & 31, hi = lane >> 5;
    bf16_t* V_lds = (bf16_t*)lds; bf16_t* K_lds = (bf16_t*)(lds + 2 * SHM_V);
    float* ws = (float*)(lds + 2 * SHM_V + 2 * SHM_K) + wid * 64; float* li_l = ws; float* al_l = ws + 32;
    float l_reg = 0; f32x16 o[4] = {}; bf16x8 qr[8];
    const bf16_t* Qw = Qb + (long)(wid * QBLK + r32) * LDQ + hi * 8;
#pragma unroll
    for (int d0 = 0; d0 < 8; ++d0) qr[d0] = *reinterpret_cast<const bf16x8*>(Qw + d0 * 16);
    const int sr = tid >> 4, sc = (tid & 15) * 8, vst0 = v_st(sr, sc), vst1 = v_st(32 + sr, sc);
    const int vb0 = (int)(uintptr_t)V_lds + v_rd_base(lane);
    struct { bf16x8 vs0, vs1, ks0, ks1; } sr_[2];
#define LD8(P) (*reinterpret_cast<const bf16x8*>(P))
#define SLOAD(i, k0) do { sr_[i].vs0 = LD8(&Vh[(long)((k0) + sr) * LDK + sc]); sr_[i].vs1 = LD8(&Vh[(long)((k0) + 32 + sr) * LDK + sc]); \
    sr_[i].ks0 = LD8(&Kh[(long)((k0) + sr) * LDK + sc]); sr_[i].ks1 = LD8(&Kh[(long)((k0) + 32 + sr) * LDK + sc]); } while (0)
    SLOAD(0, 0); SLOAD(1, KVBLK);
    {
        float ss = 0.f; int hi_ = hi; const float* qg_ = qg;
        asm volatile("" : "+v"(hi_)); asm volatile("" : "+s"(qg_));
#pragma unroll
        for (int d0 = 0; d0 < 8; ++d0) { const u32x4 w = *reinterpret_cast<const u32x4*>(&qr[d0]);
            ss += bflo(w.x) * bflo(w.x) + bfhi(w.x) * bfhi(w.x) + bflo(w.y) * bflo(w.y) + bfhi(w.y) * bfhi(w.y) + bflo(w.z) * bflo(w.z) + bfhi(w.z) * bfhi(w.z) + bflo(w.w) * bflo(w.w) + bfhi(w.w) * bfhi(w.w); }
        ss += __shfl_xor(ss, 32);
        const float rinv = rsqrtf(ss * (1.f / 128.f) + 1e-6f) * (SCALE * 1.4426950408889634f);
        const int tpos = tq0 + wid * QBLK + r32; const float* rope_ = rope; asm volatile("" : "+s"(rope_));
#pragma unroll
        for (int ax = 0; ax < 2; ++ax)
#pragma unroll
            for (int dd = 0; dd < 2; ++dd) { const int da = ax * 4 + dd, db = da + 2;
                const u32x4 wa = *reinterpret_cast<const u32x4*>(&qr[da]), wb = *reinterpret_cast<const u32x4*>(&qr[db]);
                float xa[8] = {bflo(wa.x), bfhi(wa.x), bflo(wa.y), bfhi(wa.y), bflo(wa.z), bfhi(wa.z), bflo(wa.w), bfhi(wa.w)};
                float xb[8] = {bflo(wb.x), bfhi(wb.x), bflo(wb.y), bfhi(wb.y), bflo(wb.z), bfhi(wb.z), bflo(wb.w), bfhi(wb.w)};
                const float* ga = qg_ + da * 16 + hi_ * 8; const float* gb = qg_ + db * 16 + hi_ * 8;
                const f32x4* tp = (const f32x4*)(rope_ + ((ax ? (tpos & 63) : (tpos >> 6)) * 32 + dd * 16 + hi_ * 8) * 2);
                const f32x4 t0 = tp[0], t1 = tp[1], t2 = tp[2], t3 = tp[3];
                const float csv[8] = {t0[0], t0[2], t1[0], t1[2], t2[0], t2[2], t3[0], t3[2]}, snv[8] = {t0[1], t0[3], t1[1], t1[3], t2[1], t2[3], t3[1], t3[3]};
#pragma unroll
                for (int e = 0; e < 8; ++e) { const float x1 = xa[e] * rinv * ga[e], x2 = xb[e] * rinv * gb[e];
                    xa[e] = x1 * csv[e] - x2 * snv[e]; xb[e] = x2 * csv[e] + x1 * snv[e]; }
                u32x4 oa, ob; oa.x = cvt_pk(xa[0], xa[1]); oa.y = cvt_pk(xa[2], xa[3]); oa.z = cvt_pk(xa[4], xa[5]); oa.w = cvt_pk(xa[6], xa[7]);
                ob.x = cvt_pk(xb[0], xb[1]); ob.y = cvt_pk(xb[2], xb[3]); ob.z = cvt_pk(xb[4], xb[5]); ob.w = cvt_pk(xb[6], xb[7]);
                qr[da] = *reinterpret_cast<bf16x8*>(&oa); qr[db] = *reinterpret_cast<bf16x8*>(&ob);
                __builtin_amdgcn_sched_barrier(0); }
    }
#define SWRITE(b, i) do { *(bf16x8*)((char*)V_lds + (b) * SHM_V + vst0) = sr_[i].vs0;          \
    *(bf16x8*)((char*)V_lds + (b) * SHM_V + vst1) = sr_[i].vs1; int kc = sc * 2;               \
    *(bf16x8*)((char*)K_lds + (b) * SHM_K + KSWZ(sr, kc)) = sr_[i].ks0;                       \
    *(bf16x8*)((char*)K_lds + (b) * SHM_K + KSWZ(32 + sr, kc)) = sr_[i].ks1; } while (0)
#define SWAIT() asm volatile("s_waitcnt vmcnt(4)" ::: "memory")
#define RESC(a) do { if (__any((a) < 1.f)) { if (hi == 0) al_l[r32] = (a); asm volatile("s_waitcnt lgkmcnt(0)" ::: "memory"); \
    for (int d = 0; d < 4; ++d) for (int r = 0; r < 16; ++r) o[d][r] *= al_l[crow(r, hi)]; } } while (0)
    f32x16 pA0, pA1, pB0, pB1; bf16x8 pa0, pa1, pa2, pa3; const int NT = seq / KVBLK;
    constexpr int SE = 0, SO = 1;
    asm volatile("s_waitcnt vmcnt(0)" ::: "memory"); SWRITE(0, SE); __syncthreads();
    qkt(pA0, pA1, K_lds, qr, r32, hi); partialSM(pA0, pA1, negBC);
    SLOAD(SE, 2 * KVBLK);
    SWAIT(); SWRITE(1, SO); __syncthreads();
    if (__builtin_amdgcn_readfirstlane(tid) >= 256) __builtin_amdgcn_s_setprio(1);
    for (int j = 1; j + 1 < NT; j += 2) {
        SBAR(); qkt(pB0, pB1, (bf16_t*)((char*)K_lds + SHM_K), qr, r32, hi);
        finishSM(pA0, pA1, 1.f, l_reg, pa0, pa1, pa2, pa3); SBAR();
        SLOAD(SO, (j + 2) * KVBLK); SBAR();
        pv_d0(o, vb0, pa0, pa1, pa2, pa3); partialSM(pB0, pB1, negBC);
        __syncthreads(); SWAIT(); SWRITE(0, SE);
        __syncthreads();
        SBAR(); qkt(pA0, pA1, K_lds, qr, r32, hi);
        finishSM(pB0, pB1, 1.f, l_reg, pa0, pa1, pa2, pa3); SBAR();
        SLOAD(SE, ((j + 3 < NT) ? (j + 3) : (NT - 1)) * KVBLK); SBAR();
        pv_d0(o, vb0 + (int)SHM_V, pa0, pa1, pa2, pa3); partialSM(pA0, pA1, negBC);
        __syncthreads(); SWAIT(); SWRITE(1, SO);
        __syncthreads();
    }
    SBAR(); qkt(pB0, pB1, (bf16_t*)((char*)K_lds + SHM_K), qr, r32, hi);
    finishSM(pA0, pA1, 1.f, l_reg, pa0, pa1, pa2, pa3); SBAR();
    pv_d0(o, vb0, pa0, pa1, pa2, pa3); partialSM(pB0, pB1, negBC);
    __syncthreads();
    finishSM(pB0, pB1, 1.f, l_reg, pa0, pa1, pa2, pa3); SBAR();
    pv_d0(o, vb0 + (int)SHM_V, pa0, pa1, pa2, pa3);
    __builtin_amdgcn_s_setprio(0);
    if (hi == 0) li_l[r32] = l_reg; asm volatile("s_waitcnt lgkmcnt(0)" ::: "memory");
    float rli[16];
#pragma unroll
    for (int r = 0; r < 16; ++r) rli[r] = __builtin_amdgcn_rcpf(li_l[crow(r, hi)]);
    u32x4 zr[8];
#pragma unroll
    for (int i = 0; i < 8; ++i) { const int idx = tid + 512 * i; zr[i] = *(const u32x4*)(Zb + (long)(idx >> 4) * LDP + (idx & 15) * 8); }
    __syncthreads();
    float* Ol = (float*)lds;
#pragma unroll
    for (int r = 0; r < 16; ++r) { const int orow = wid * QBLK + crow(r, hi);
#pragma unroll
        for (int d0 = 0; d0 < 4; ++d0) Ol[orow * 132 + d0 * 32 + r32] = o[d0][r] * rli[r]; }
    __syncthreads();
#pragma unroll
    for (int i = 0; i < 8; ++i) { const int idx = tid + 512 * i, row = idx >> 4, c8 = (idx & 15) * 8;
        const f32x4 a = *(const f32x4*)(Ol + row * 132 + c8), b = *(const f32x4*)(Ol + row * 132 + c8 + 4);
        const u32x4 z = zr[i];
        u32x4 w; w.x = cvt_pk(a[0] * bflo(z.x), a[1] * bfhi(z.x)); w.y = cvt_pk(a[2] * bflo(z.y), a[3] * bfhi(z.y));
        w.z = cvt_pk(b[0] * bflo(z.z), b[1] * bfhi(z.z)); w.w = cvt_pk(b[2] * bflo(z.w), b[3] * bfhi(z.w));
        *(u32x4*)(Ob + (long)row * 1024 + c8) = w; }
    __syncthreads();
#undef LD8
#undef SLOAD
#undef SWRITE
#undef SWAIT
#undef RESC
}
}

__device__ void phase_attn(const Params& p, unsigned char* smem) {
    const bf16_t* P1 = (const bf16_t*)p.ws; bf16_t* OG = (bf16_t*)p.out + (size_t)MTOK * 1024;
    const int x = blockIdx.x & 7, wl = blockIdx.x >> 3;
    float gqm = 0.f, gkm = 0.f;
    for (int i = 0; i < 128; ++i) { gqm = fmaxf(gqm, fabsf(p.qng[i])); gkm = fmaxf(gkm, fabsf(p.kng[i])); }
    const float bound2 = (11.313708498984761f * 1.02f * gqm * gkm) * 1.4426950408889634f;
    const float negBC = bound2 > 64.f ? 64.f - bound2 : 0.f;
    for (int slot_ = 0; slot_ < (REP_PH == 5 ? 16 : 8); ++slot_) { const int slot = slot_ & 7;
        int pair, u, T, rb, hq, qb;
        if (slot < 4) { pair = x + 8 * (slot >> 1); u = wl + 32 * (slot & 1); T = 4096; rb = (pair >> 1) * 4096; hq = u >> 4; qb = u & 15; }
        else { pair = x + 8 * (slot - 4); u = wl; T = 2048; rb = NPROMPT + (pair >> 1) * 2048; hq = u >> 3; qb = u & 7; }
        const int kvh = pair & 1, hg = kvh * 4 + hq; const size_t q0 = (size_t)rb + qb * 256;
        att::attn_body(P1 + q0 * LDP + hg * 128, P1 + (size_t)rb * LDP + 1024 + kvh * 128, P1 + (size_t)rb * LDP + 1280 + kvh * 128,
                       P1 + q0 * LDP + 1536 + hg * 128, OG + q0 * 1024 + hg * 128, T, (char*)smem, qb * 256, p.qng, (const float*)(p.ws + OFF_ROPE), negBC);
    }
}


__device__ void panel_gates(const bf16_t* XB, const bf16_t* Wg  , float* gates, int r0) {
    int tid = threadIdx.x; asm volatile("" : "+v"(tid));
    const int wid = tid >> 6, lane = tid & 63, li = lane & 15, kq = lane >> 4;
    const bf16_t* xa = XB + (size_t)(r0 + (2 * wid) * 16 + li) * 1024 + kq * 8;
    const bf16_t* xb = xa + 16 * 1024;
    const bf16_t* wp = Wg + (size_t)li * 1024 + kq * 8;
    f32x4 acc0 = {0.f, 0.f, 0.f, 0.f}, acc1 = {0.f, 0.f, 0.f, 0.f};
    for (int kc = 0; kc < 4; ++kc) {
        bf16x8 wf[8], x0[8], x1[8];
#pragma unroll
        for (int u = 0; u < 8; ++u) { const int ko = (kc * 8 + u) * 32; wf[u] = *(const bf16x8*)(wp + ko); x0[u] = *(const bf16x8*)(xa + ko); x1[u] = *(const bf16x8*)(xb + ko); }
#pragma unroll
        for (int u = 0; u < 8; ++u) { acc0 = __builtin_amdgcn_mfma_f32_16x16x32_bf16(wf[u], x0[u], acc0, 0, 0, 0); acc1 = __builtin_amdgcn_mfma_f32_16x16x32_bf16(wf[u], x1[u], acc1, 0, 0, 0); }
    }
    *(f32x4*)(gates + (size_t)(r0 + (2 * wid) * 16 + li) * 16 + kq * 4) = acc0;
    *(f32x4*)(gates + (size_t)(r0 + (2 * wid + 1) * 16 + li) * 16 + kq * 4) = acc1;
}

#define XB_TMO      128
#define XB_XCNT(j)  (256  + 64 * (j))
#define XB_XSUB(j)  (1280 + 64 * (j))
#define XB_XGEN(j)  (2304 + 64 * (j))
#define XB_TOP      3328
#define XB_TOPGEN   3392
#define XCD_BAR_WORDS 3456
#define XB_SPIN_CAP (1u << 18)
__device__ __forceinline__ unsigned xb_ld(unsigned* p)              { return __hip_atomic_load(p, __ATOMIC_RELAXED, __HIP_MEMORY_SCOPE_AGENT); }
__device__ __forceinline__ unsigned xb_add(unsigned* p, unsigned v) { return __hip_atomic_fetch_add(p, v, __ATOMIC_RELAXED, __HIP_MEMORY_SCOPE_AGENT); }
__device__ __forceinline__ unsigned xb_xcc_id() { return (unsigned)__builtin_amdgcn_s_getreg((3 << 11) | 20) & 0xFu; }
#define XB_SPIN(cond, bar) do { unsigned _sp = 0; while (cond) { __builtin_amdgcn_s_sleep(1); \
    if ((++_sp & 255u) == 0u) { if (xb_ld(&(bar)[XB_TMO])) break; if (_sp > XB_SPIN_CAP) { atomicAdd(&(bar)[XB_TMO], 1u); break; } } } } while (0)
struct XcdBarrier { unsigned* bar; unsigned x; volatile LAS unsigned* st; };
__device__ __forceinline__ XcdBarrier xcd_barrier_post(unsigned* bar, volatile LAS unsigned* st) {
    XcdBarrier b; b.bar = bar; b.x = xb_xcc_id(); b.st = st;
    if (threadIdx.x == 0) (void)xb_add(&bar[XB_XCNT(b.x)], 1u);
    return b;
}
__device__ __forceinline__ void xcd_barrier_complete(unsigned* bar, unsigned x, unsigned& nloc, unsigned& nx) {
    const unsigned G = gridDim.x * gridDim.y * gridDim.z;
    unsigned sum, cnt, mine, sp = 0u;
    for (;;) {
        sum = 0u; cnt = 0u; mine = 0u;
#pragma unroll
        for (unsigned j = 0; j < 16; ++j) { const unsigned c = xb_ld(&bar[XB_XCNT(j)]); sum += c; cnt += (c > 0u) ? 1u : 0u; mine = (j == x) ? c : mine; }
        if (sum == G) break;
        __builtin_amdgcn_s_sleep(1);
        if ((++sp & 255u) == 0u) { if (xb_ld(&bar[XB_TMO])) break; if (sp > XB_SPIN_CAP) { atomicAdd(&bar[XB_TMO], 1u); break; } }
    }
    nloc = mine > 0u ? mine : 1u; nx = cnt > 0u ? cnt : 1u;
}
__device__ __forceinline__ void xcd_barrier(const XcdBarrier& b) {
    asm volatile("s_waitcnt vmcnt(0)" ::: "memory");
    __syncthreads();
    if (threadIdx.x == 0) {
        unsigned* bar = b.bar;
        __builtin_amdgcn_s_waitcnt(0);
        unsigned nloc = b.st[0], nx = b.st[1];
        if (nloc == 0u) { xcd_barrier_complete(bar, b.x, nloc, nx); b.st[0] = nloc; b.st[1] = nx; }
        const unsigned old = xb_add(&bar[XB_XSUB(b.x)], 1u);
        const unsigned gen = old / nloc;
        if (old + 1u == (gen + 1u) * nloc) {
            __builtin_amdgcn_fence(__ATOMIC_RELEASE, "agent");
            asm volatile("s_waitcnt vmcnt(0)" ::: "memory");
            const unsigned og = xb_add(&bar[XB_TOP], 1u);
            const unsigned tg = og / nx;
            if (og + 1u == (tg + 1u) * nx) xb_add(&bar[XB_TOPGEN], 1u);
            else XB_SPIN(xb_ld(&bar[XB_TOPGEN]) == tg, bar);
            __builtin_amdgcn_fence(__ATOMIC_ACQUIRE, "agent");
            xb_add(&bar[XB_XGEN(b.x)], 1u);
            asm volatile("s_waitcnt vmcnt(0)" ::: "memory");
        } else {
            XB_SPIN(xb_ld(&bar[XB_XGEN(b.x)]) == gen, bar);
            __builtin_amdgcn_fence(__ATOMIC_ACQUIRE, "agent");
            asm volatile("s_waitcnt vmcnt(0)" ::: "memory");
        }
    }
    __syncthreads();
}

__global__ __launch_bounds__(512, 2) void mk_fwd(Params p) {
    extern __shared__ __attribute__((aligned(16))) unsigned char smem[];
    cg::grid_group grid = cg::this_grid();
    LAS unsigned char* lds = (LAS unsigned char*)smem;
    bf16_t* P0 = (bf16_t*)p.ws; float* Y = (float*)p.ws;
    bf16_t* XB = (bf16_t*)p.out; bf16_t* CAT0 = XB + (size_t)MTOK * 1024;
#ifndef ONLY_PH
#define ONLY_PH -1
#endif
#define RUN(n) (p.ph_lo <= (n) && (n) < p.ph_hi && (ONLY_PH < 0 || ONLY_PH == (n)))
#define REPEAT(n) for (int rep_ = 0; rep_ < ((REP_PH == (n)) ? 2 : 1); ++rep_)
#define SYNC(n) do { if (p.ph_lo <= (n) && (n) + 1 < p.ph_hi) { if ((n) == 0 || MK_MULTI) { grid.sync(); if ((n) == 0) xb = xcd_barrier_post((unsigned*)(p.ws + OFF_BAR), xst); } else xcd_barrier(xb); } } while (0)
    volatile LAS unsigned* xst = (volatile LAS unsigned*)(lds + (LDS_BYTES - 16));
    if (threadIdx.x == 0) { xst[0] = 0u; xst[1] = 0u; }
    __syncthreads();
    XcdBarrier xb; xb.bar = (unsigned*)(p.ws + OFF_BAR); xb.x = 0u; xb.st = xst;
    if (RUN(0)) phase_prep(p, smem);
    if (REP_PH == 0) { grid.sync(); phase_prep(p, smem); }
    SYNC(0);
    if (REP_PH == 13) { grid.sync(); grid.sync(); grid.sync(); grid.sync(); }
    if (RUN(1)) {
        pg8::PanelOrder S{(int)blockIdx.x, 12};
        pg8::EpiP0 E{P0, (float*)(p.ws + OFF_GATES)};
        pg8::gemm_phase(lds, pg8::Gemm{XB, (const bf16_t*)(p.ws + OFF_WT0), MTOK, 3072, 1024, 1024}, S, E);
        panel_gates(XB, (const bf16_t*)(p.ws + OFF_WT0) + (size_t)3072 * 1024, (float*)(p.ws + OFF_GATES), (int)blockIdx.x * 256);
    }
    SYNC(1);
    if (RUN(2)) phase_mix(p, smem);
    SYNC(2);
    if (RUN(3)) phase_scan(p, smem);
    SYNC(3);
    if (RUN(4)) {
        const int pm = blockIdx.x, r0 = pm * 256;
        panel_outb(p, r0);
        __builtin_amdgcn_fence(__ATOMIC_SEQ_CST, "workgroup"); __syncthreads();
        { pg8::PanelOrder S{pm, 4}; pg8::EpiRes<0> E{P0, nullptr};
          pg8::gemm_phase(lds, pg8::Gemm{CAT0, (const bf16_t*)(p.ws + OFF_WO0T), MTOK, 1024, 1024, 1024}, S, E); }
        __builtin_amdgcn_fence(__ATOMIC_SEQ_CST, "workgroup"); __syncthreads();
        panel_ln<0>(P0, p.xp, p.xs, p.ln_g, p.ln_b, XB, r0);
        __builtin_amdgcn_fence(__ATOMIC_SEQ_CST, "workgroup"); __syncthreads();
        { pg8::PanelOrder S{pm, 10}; pg8::EpiBf E{P0};
          pg8::gemm_phase(lds, pg8::Gemm{XB, (const bf16_t*)(p.ws + OFF_WT1), MTOK, 2560, 1024, 1024}, S, E); }
        __builtin_amdgcn_fence(__ATOMIC_SEQ_CST, "workgroup"); __syncthreads();
        panel_qknorm(p, r0);
    }
    SYNC(4);
    if (RUN(5)) phase_attn(p, smem);
    SYNC(5);
    if (RUN(6)) {
        pg8::PanelOrder S{(int)blockIdx.x, 4}; pg8::EpiRes<1> E{P0, XB};
        pg8::gemm_phase(lds, pg8::Gemm{CAT0, (const bf16_t*)(p.ws + OFF_WO1T), MTOK, 1024, 1024, 1024}, S, E);
    }
    SYNC(6);
    if (RUN(7)) panel_ln<1>(P0, nullptr, nullptr, p.ln_g + 1024, p.ln_b + 1024, p.out, (int)blockIdx.x * 256);
}

extern "C" void kernel_launch(void* const* d_in, const int* in_sizes, int n_in, void* d_out, int out_size, void* d_ws, size_t ws_size, hipStream_t stream) {
    static int ok = 0;
    if (ok == 0) {
        if (n_in != 20 || out_size != MTOK * DM || ws_size < WS_END) { fprintf(stderr, "kernel_launch: unexpected shapes n_in %d out %d ws %zu (need %zu)\n", n_in, out_size, ws_size, (size_t)WS_END); ok = -1; return; }
        if (hipFuncSetAttribute((const void*)mk_fwd, hipFuncAttributeMaxDynamicSharedMemorySize, LDS_BYTES) != hipSuccess) { fprintf(stderr, "kernel_launch: hipFuncSetAttribute failed\n"); ok = -1; return; }
        int dev = 0, cus = 0, per_cu = 0;
        hipGetDevice(&dev); hipDeviceGetAttribute(&cus, hipDeviceAttributeMultiprocessorCount, dev);
        hipOccupancyMaxActiveBlocksPerMultiprocessor(&per_cu, (const void*)mk_fwd, 512, LDS_BYTES);
        if (cus * per_cu < 256) { fprintf(stderr, "kernel_launch: %d CUs x %d blocks cannot hold the 256-workgroup grid\n", cus, per_cu); ok = -1; return; }
        ok = 1;
    }
    if (ok < 0) return;
    Params p{};
    p.xp = (const float*)d_in[0]; p.xs = (const float*)d_in[1]; p.w_in_even = (const float*)d_in[2]; p.w_pool = (const float*)d_in[3]; p.pool_scale = (const float*)d_in[4];
    p.conv_w = (const float*)d_in[5]; p.conv_b = (const float*)d_in[6]; p.w_q = (const float*)d_in[7]; p.w_k = (const float*)d_in[8]; p.bgi = (const float*)d_in[9];
    p.bgf = (const float*)d_in[10]; p.mh_g = (const float*)d_in[11]; p.skip = (const float*)d_in[12]; p.w_out_even = (const float*)d_in[13]; p.w_in_odd = (const float*)d_in[14];
    p.qng = (const float*)d_in[15]; p.kng = (const float*)d_in[16]; p.w_out_odd = (const float*)d_in[17]; p.ln_g = (const float*)d_in[18]; p.ln_b = (const float*)d_in[19];
    p.out = (float*)d_out; p.ws = (unsigned char*)d_ws;
#if MK_MULTI
    for (int ph = 0; ph < 8; ++ph) { p.ph_lo = ph; p.ph_hi = ph + 1; void* args[] = {&p};
        hipError_t e = hipLaunchCooperativeKernel((const void*)mk_fwd, dim3(256), dim3(512), args, LDS_BYTES, stream);
        if (e != hipSuccess) { fprintf(stderr, "kernel_launch: launch %d failed: %s\n", ph, hipGetErrorString(e)); return; } }
#else
    p.ph_lo = 0; p.ph_hi = 8; void* args[] = {&p};
    hipError_t e = hipLaunchCooperativeKernel((const void*)mk_fwd, dim3(256), dim3(512), args, LDS_BYTES, stream);
    if (e != hipSuccess) fprintf(stderr, "kernel_launch: cooperative launch failed: %s\n", hipGetErrorString(e));
#endif
}
```
